# Optimizing an MI355X kernel written in HIP

```python
import math
import jax, jax.numpy as jnp
from jax import lax
import numpy as np

D_MODEL = 1024
BATCH = 4
SEQ = 8192
DEPTH = 2

N_ATT_HEADS = 4
QK_DIM = 64
V_DIM = 2 * QK_DIM
ATT_QK_WIDTH = N_ATT_HEADS * 2 * QK_DIM
ATT_WIDTH = N_ATT_HEADS * V_DIM
POOL_WINDOWS = (2, 4, 8, 16)
N_POOL_GROUPS = len(POOL_WINDOWS)
POOL_WIDTH = D_MODEL - ATT_WIDTH
POOL_GROUP_DIM = POOL_WIDTH // N_POOL_GROUPS
MIX_WIDTH = ATT_WIDTH + POOL_WIDTH
IN_WIDTH = 2 * ATT_QK_WIDTH + ATT_WIDTH + POOL_WIDTH
N_BUCKETS = 32
MAX_DISTANCE = 128
Q_BLOCK = 128
N_EXPERTS = 32
TOP_K = 4
D_FF = D_MODEL
SWIGLU_LIMIT = 7.0
SWIGLU_ALPHA = 1.702
EXPERT_BLOCK = 128
EPS = 1e-5

kernel_name = "hybrid_diffattn_pool_moe_encoder"


def rmsnorm(x, g):
    xf = x.astype(jnp.float32)
    y = xf * lax.rsqrt(jnp.mean(xf * xf, axis=-1, keepdims=True) + EPS)
    return (y * g.astype(jnp.float32)).astype(x.dtype)


def rel_bucket(rel):
    nb = N_BUCKETS // 2
    max_exact = nb // 2
    ret = jnp.where(rel > 0, nb, 0)
    n = jnp.abs(rel)
    n_f = jnp.maximum(n, 1).astype(jnp.float32)
    large = max_exact + (jnp.log(n_f / max_exact) / math.log(MAX_DISTANCE / max_exact)
                         * (nb - max_exact)).astype(jnp.int32)
    large = jnp.minimum(large, nb - 1)
    return ret + jnp.where(n < max_exact, n, large)


def diff_attention(q, k, v, rel_table, lam, sub_g, lam_init):
    B, S = q.shape[0], q.shape[1]
    scale = QK_DIM ** -0.5
    q = jnp.transpose(q, (0, 2, 3, 1, 4)) * scale
    k = jnp.transpose(k, (0, 2, 3, 1, 4))
    v = jnp.transpose(v, (0, 2, 1, 3))
    kpos = jnp.arange(S, dtype=jnp.int32)

    def block(i):
        start = i * Q_BLOCK
        qb = lax.dynamic_slice_in_dim(q, start, Q_BLOCK, axis=3)
        logits = jnp.einsum('bhmqd,bhmkd->bhmqk', qb, k).astype(jnp.float32)
        qpos = start + jnp.arange(Q_BLOCK, dtype=jnp.int32)
        bias = rel_table.astype(jnp.float32)[rel_bucket(kpos[None, :] - qpos[:, None])]
        bias = jnp.transpose(bias, (2, 0, 1))
        p = jax.nn.softmax(logits + bias[None, :, None], axis=-1)
        a = p[:, :, 0] - lam * p[:, :, 1]
        return jnp.einsum('bhqk,bhkd->bhqd', a.astype(v.dtype), v)

    o = lax.map(block, jnp.arange(S // Q_BLOCK))
    o = jnp.transpose(o, (1, 0, 3, 2, 4)).reshape(B, S, N_ATT_HEADS, V_DIM)
    o = rmsnorm(o, sub_g) * (1.0 - lam_init)
    return o.reshape(B, S, ATT_WIDTH)


def pool_mixer(p, w_pool, pool_scale):
    B, S, C = p.shape
    pf = p.astype(jnp.float32)
    c = jnp.concatenate([jnp.zeros((B, 1, C), jnp.float32), jnp.cumsum(pf, axis=1)], axis=1)
    t = jnp.arange(S, dtype=jnp.int32)
    outs = []
    for g, win in enumerate(POOL_WINDOWS):
        lo = jnp.maximum(t - win // 2, 0)
        hi = jnp.minimum(t - win // 2 + win - 1, S - 1)
        sl = slice(g * POOL_GROUP_DIM, (g + 1) * POOL_GROUP_DIM)
        cg = c[:, :, sl]
        s = jnp.take(cg, hi + 1, axis=1) - jnp.take(cg, lo, axis=1)
        mean = s / (hi - lo + 1).astype(jnp.float32)[None, :, None]
        d = (mean - pf[:, :, sl]).astype(p.dtype)
        outs.append(d @ w_pool[g])
    return jnp.concatenate(outs, axis=-1) * pool_scale


def moe(h, w_router, b_router, w_gate, b_gate, w_up, b_up, w_down, b_down):
    B, S, D = h.shape
    N = B * S
    hf = h.reshape(N, D)
    logits = (hf @ w_router + b_router).astype(jnp.float32)
    topv, topi = lax.top_k(logits, TOP_K)
    gates = jax.nn.softmax(topv, axis=-1)
    A = N * TOP_K
    flat_e = topi.reshape(A)
    flat_tok = jnp.repeat(jnp.arange(N, dtype=jnp.int32), TOP_K)
    flat_g = gates.reshape(A)
    order = jnp.argsort(flat_e)
    sorted_e = flat_e[order]
    sorted_tok = flat_tok[order]
    sorted_g = flat_g[order]
    counts = jnp.zeros((N_EXPERTS,), jnp.int32).at[flat_e].add(1)
    starts = jnp.cumsum(counts) - counts
    padded = ((counts + EXPERT_BLOCK - 1) // EXPERT_BLOCK) * EXPERT_BLOCK
    padded_ends = jnp.cumsum(padded)
    padded_starts = padded_ends - padded
    rank = jnp.arange(A, dtype=jnp.int32) - starts[sorted_e]
    dest = padded_starts[sorted_e] + rank
    NB = -(-(A + N_EXPERTS * (EXPERT_BLOCK - 1)) // EXPERT_BLOCK)
    P = NB * EXPERT_BLOCK
    row_tok = jnp.zeros((P,), jnp.int32).at[dest].set(sorted_tok)
    row_gate = jnp.zeros((P,), jnp.float32).at[dest].set(sorted_g)
    block_start = jnp.arange(NB, dtype=jnp.int32) * EXPERT_BLOCK
    block_expert = jnp.clip(jnp.searchsorted(padded_ends, block_start, side='right'), 0, N_EXPERTS - 1)

    def expert_block(args):
        e, tok, gt = args
        xb = hf[tok]
        g = xb @ w_gate[e] + b_gate[e]
        u = xb @ w_up[e] + b_up[e]
        g = jnp.minimum(g, SWIGLU_LIMIT)
        u = jnp.clip(u, -SWIGLU_LIMIT, SWIGLU_LIMIT)
        act = (u + 1.0) * (g * jax.nn.sigmoid(g * SWIGLU_ALPHA))
        y = act @ w_down[e] + b_down[e]
        return y * gt[:, None].astype(y.dtype)

    y = lax.map(expert_block, (block_expert, row_tok.reshape(NB, EXPERT_BLOCK),
                               row_gate.reshape(NB, EXPERT_BLOCK)))
    out = jnp.zeros((N, D), h.dtype).at[row_tok].add(y.reshape(P, D).astype(h.dtype))
    return out.reshape(B, S, D)


def setup_inputs(seed: int = 0) -> dict:
    key = jax.random.key(seed)
    ks = jax.random.split(key, 24)
    nrm = lambda k, shape, s: jax.random.normal(k, shape, jnp.float32) * s
    L, D, E, F = DEPTH, D_MODEL, N_EXPERTS, D_FF
    return {
        "x": nrm(ks[0], (BATCH, SEQ, D), 1.0),
        "rel_table": nrm(ks[1], (N_BUCKETS, N_ATT_HEADS), 0.5),
        "norm1": 1.0 + nrm(ks[2], (L, D), 0.05),
        "w_in": nrm(ks[3], (L, D, IN_WIDTH), D ** -0.5),
        "lambda_q1": nrm(ks[4], (L, QK_DIM), 0.1),
        "lambda_k1": nrm(ks[5], (L, QK_DIM), 0.1),
        "lambda_q2": nrm(ks[6], (L, QK_DIM), 0.1),
        "lambda_k2": nrm(ks[7], (L, QK_DIM), 0.1),
        "subln_g": 1.0 + nrm(ks[8], (L, V_DIM), 0.05),
        "w_pool": nrm(ks[9], (L, N_POOL_GROUPS, POOL_GROUP_DIM, POOL_GROUP_DIM), POOL_GROUP_DIM ** -0.5),
        "pool_scale": 1.0 + nrm(ks[10], (L, POOL_WIDTH), 0.1),
        "w_out": nrm(ks[11], (L, MIX_WIDTH, D), MIX_WIDTH ** -0.5),
        "norm2": 1.0 + nrm(ks[12], (L, D), 0.05),
        "w_router": nrm(ks[13], (L, D, E), D ** -0.5),
        "b_router": nrm(ks[14], (L, E), 0.01),
        "w_gate": nrm(ks[15], (L, E, D, F), D ** -0.5),
        "b_gate": nrm(ks[16], (L, E, F), 0.01),
        "w_up": nrm(ks[17], (L, E, D, F), D ** -0.5),
        "b_up": nrm(ks[18], (L, E, F), 0.01),
        "w_down": nrm(ks[19], (L, E, F, D), F ** -0.5),
        "b_down": nrm(ks[20], (L, E, D), 0.01),
        "final_norm": 1.0 + nrm(ks[21], (D,), 0.05),
    }


def reference(x, rel_table, norm1, w_in, lambda_q1, lambda_k1, lambda_q2, lambda_k2,
              subln_g, w_pool, pool_scale, w_out, norm2, w_router, b_router,
              w_gate, b_gate, w_up, b_up, w_down, b_down, final_norm):
    B, S, D = x.shape
    for l in range(DEPTH):
        h = rmsnorm(x, norm1[l])
        proj = h @ w_in[l]
        q = proj[..., :ATT_QK_WIDTH].reshape(B, S, N_ATT_HEADS, 2, QK_DIM)
        k = proj[..., ATT_QK_WIDTH:2 * ATT_QK_WIDTH].reshape(B, S, N_ATT_HEADS, 2, QK_DIM)
        v = proj[..., 2 * ATT_QK_WIDTH:2 * ATT_QK_WIDTH + ATT_WIDTH].reshape(B, S, N_ATT_HEADS, V_DIM)
        p = proj[..., 2 * ATT_QK_WIDTH + ATT_WIDTH:]
        lam_init = 0.8 - 0.6 * math.exp(-0.3 * l)
        lam = (jnp.exp(jnp.sum(lambda_q1[l].astype(jnp.float32) * lambda_k1[l].astype(jnp.float32)))
               - jnp.exp(jnp.sum(lambda_q2[l].astype(jnp.float32) * lambda_k2[l].astype(jnp.float32)))
               + lam_init)
        att = diff_attention(q, k, v, rel_table, lam, subln_g[l], lam_init)
        pool = pool_mixer(p, w_pool[l], pool_scale[l])
        x = x + jnp.concatenate([att, pool], axis=-1) @ w_out[l]
        x = x + moe(rmsnorm(x, norm2[l]), w_router[l], b_router[l], w_gate[l], b_gate[l],
                    w_up[l], b_up[l], w_down[l], b_down[l])
    return rmsnorm(x, final_norm)
```

```cpp
#include <hip/hip_runtime.h>
#include <cstdio>
#include <cstdint>

#define LAS __attribute__((address_space(3)))
#define GAS __attribute__((address_space(1)))
typedef unsigned short bf16_t;
typedef short bf16x8 __attribute__((ext_vector_type(8)));
typedef short s16x4 __attribute__((ext_vector_type(4)));
typedef float f32x2 __attribute__((ext_vector_type(2)));
typedef float f32x4 __attribute__((ext_vector_type(4)));
typedef int i32x8 __attribute__((ext_vector_type(8)));
typedef float f32x16 __attribute__((ext_vector_type(16)));
typedef unsigned u32x2 __attribute__((ext_vector_type(2)));
typedef unsigned u32x4 __attribute__((ext_vector_type(4)));
typedef GAS unsigned gu32;

constexpr int D = 1024, BATCH = 4, SEQ = 8192, NTOK = BATCH * SEQ, DEPTH = 2;
constexpr int NH = 4, INW = 2048, NE = 32, TOPK = 4, NASG = NTOK * TOPK;
constexpr float EPS = 1e-5f, LOG2E = 1.4426950408889634f;
constexpr float QSCALE = 0.125f * LOG2E;
constexpr int NWAVES = 8;

constexpr size_t MiB = 1u << 20;
constexpr size_t WS_CTL = 0, CTL_ZERO_BYTES = 1 * MiB;
constexpr size_t WS_WIN = 1 * MiB;
constexpr size_t WS_WOUT = 9 * MiB;
constexpr size_t WS_WPOOL = 13 * MiB;
constexpr size_t WS_ROUTE = 14 * MiB;
constexpr size_t WS_WGU = 18 * MiB;
constexpr size_t WS_WDN = 146 * MiB;
constexpr size_t WS_X = 210 * MiB;
constexpr size_t WS_RA = 338 * MiB;
constexpr size_t WS_RB = 595 * MiB;
constexpr size_t RT_TL = 852 * MiB, RT_GL = 856 * MiB;
constexpr size_t WS_END = 864 * MiB;
constexpr size_t RA_QKVP = WS_RA, RA_MIX = WS_RA + 128 * MiB, RA_H = WS_RA + 192 * MiB;
constexpr size_t RT_E = WS_ROUTE, RT_RANK = WS_ROUTE + 512 * 1024, RT_GATE = WS_ROUTE + 1024 * 1024, RT_POS = WS_ROUTE + 1536 * 1024, RT_GS = WS_ROUTE + 2048 * 1024;
constexpr int CW_BAR = 4096, CW_ECNT = 16384;

constexpr int RING_BYTES = 131072;
constexpr int LDSCTL_OFF = RING_BYTES;
constexpr int MISC_OFF = LDSCTL_OFF + 320;
constexpr int TAB_OFF = LDSCTL_OFF + 1024;
constexpr int GTAB_OFF_ = 133120;
constexpr int LDS_BYTES = 163840;

#define LDS_WAIT() asm volatile("s_waitcnt lgkmcnt(0)" ::: "memory")
#define VM_WAIT() asm volatile("s_waitcnt vmcnt(0)" ::: "memory")
__device__ __forceinline__ unsigned f2bf(float f) { unsigned u = __builtin_bit_cast(unsigned, f); return (u + 0x7fffu + ((u >> 16) & 1u)) >> 16; }
__device__ __forceinline__ unsigned pk2(float lo, float hi) { return f2bf(lo) | (f2bf(hi) << 16); }
__device__ __forceinline__ float bf2f(unsigned short b) { return __builtin_bit_cast(float, (unsigned)b << 16); }
__device__ __forceinline__ unsigned cvt_pk_bf16(float lo, float hi) { unsigned r; asm volatile("v_cvt_pk_bf16_f32 %0, %1, %2" : "=v"(r) : "v"(lo), "v"(hi)); return r; }
__device__ __forceinline__ int rfl(int v) { return __builtin_amdgcn_readfirstlane(v); }
__device__ __forceinline__ unsigned pk4_fp8(float a, float b, float c, float d) { int w; asm("" : "=v"(w)); w = __builtin_amdgcn_cvt_pk_fp8_f32(a, b, w, false); return (unsigned)__builtin_amdgcn_cvt_pk_fp8_f32(c, d, w, true); }

namespace pg8 {
constexpr int BM = 256, BK = 64, HALF = 128, HTB = HALF * BK * 2, STAGE_BYTES = 8 * HTB, NXCD = 8, WGM = 8;
constexpr int GTAB_OFF = 133120, GTAB_UNITS = 17;
constexpr float F8_SH = 8.0f, F8_SG = 64.0f;
constexpr float F8_SY = 4.0f;
constexpr float F8_SA = 4.0f, F8_SW = 64.0f;
__host__ __device__ __forceinline__ int lds_byte(int r, int c) { const int st = (r >> 4) * 2 + (c >> 5), rr = r & 15, cc = c & 31, ob = rr * 64 + cc * 2; return st * 1024 + (ob ^ (((ob >> 9) & 1) << 5)); }
__host__ __device__ __forceinline__ void stage_rc(int b, int& R, int& C) { const int st = b / 1024, sb = b % 1024, swz = sb ^ (((sb >> 9) & 1) << 5); R = (st >> 1) * 16 + swz / 64; C = (st & 1) * 32 + (swz % 64) / 2; }
__host__ __device__ __forceinline__ int perm32(int rho) { const int n = rho >> 4, i = rho & 15; return 8 * (i >> 2) + 4 * n + (i & 3); }

struct Unit { int arow, brow, orow, ocol, valid, e, grow; };
struct Gemm { const bf16_t* A; const bf16_t* Bt; int K; const int* tl; };

struct DenseOrder {
    int nM, nN, nwg, G, c;
    __device__ void init(int M, int N, int G_, int c_) { nM = M / BM; nN = N / BM; nwg = nM * nN; G = G_; c = c_; }
    __device__ bool next(int i, Unit& u) const {
        const long L = (long)i * G + c; if (L >= nwg) return false;
        int wgid = (int)L; { const int q = nwg / NXCD, r = nwg % NXCD, xcd = wgid % NXCD, off = wgid / NXCD; wgid = (xcd < r ? xcd * (q + 1) : r * (q + 1) + (xcd - r) * q) + off; }
        const int nig = WGM * nN, gid = wgid / nig, fm = gid * WGM, gsz = (nM - fm) < WGM ? (nM - fm) : WGM;
        const int pm = fm + ((wgid % nig) % gsz), pn = (wgid % nig) / gsz;
        u.arow = pm * BM; u.brow = pn * BM; u.orow = pm * BM; u.ocol = pn * BM; u.valid = BM; u.e = 0; u.grow = 0; return true;
    }
};
struct MoeOrder {
    const LAS int* tab; int nct, nb, ocw, total, G, c, rev;
    __device__ bool next(int i, Unit& u) const {
        const long L = (long)i * G + c; if (L >= total) return false;
        int wgid = (int)L; { const int q = total / NXCD, r = total % NXCD, xcd = wgid % NXCD, off = wgid / NXCD, len = q + (xcd < r ? 1 : 0); wgid = (xcd < r ? xcd * (q + 1) : r * (q + 1) + (xcd - r) * q) + (rev ? len - 1 - off : off); }
        const int T = wgid / nct, pn = wgid % nct;
        const int ln = (int)__builtin_amdgcn_mbcnt_hi(~0u, __builtin_amdgcn_mbcnt_lo(~0u, 0u)) & 31;
        const int tpv = tab[ln], rbv = tab[33 + ln], cnv = tab[66 + ln];
        const int e = __builtin_popcountll(__builtin_amdgcn_ballot_w64(T >= tpv)) / 2 - 1;
        const int rt = T - __builtin_amdgcn_readlane(tpv, e); const int rb = __builtin_amdgcn_readlane(rbv, e), cn = __builtin_amdgcn_readlane(cnv, e);
        const int left = cn - BM * rt;
        u.e = e; u.arow = rb + BM * rt; u.orow = u.arow; u.valid = left < BM ? left : BM; u.brow = e * nb + pn * BM; u.ocol = pn * ocw; u.grow = e * NTOK + BM * rt; return true;
    }
};

struct EpiQkvp {
    static constexpr bool PERM = true;
    bf16_t* O;
    __device__ __forceinline__ void init(f32x4 (&acc)[2][2][4][2], const Unit&, int, int) const {
#pragma unroll
        for (int a = 0; a < 2; ++a)
#pragma unroll
            for (int b = 0; b < 2; ++b)
#pragma unroll
                for (int m = 0; m < 4; ++m)
#pragma unroll
                    for (int n = 0; n < 2; ++n) acc[a][b][m][n] = (f32x4){0.f, 0.f, 0.f, 0.f};
    }
    __device__ __forceinline__ void operator()(const f32x4 (&acc)[2][2][4][2], const Unit& u, int wr, int wc, int fr, int fq) const {
        const int row0 = u.orow + wr * 64 + fr, col0 = u.ocol + wc * 32 + 8 * fq; const float sc = (u.ocol < 512) ? QSCALE : 1.f;
#pragma unroll
        for (int ai = 0; ai < 2; ++ai)
#pragma unroll
            for (int m = 0; m < 4; ++m) { bf16_t* rowp = O + (size_t)(row0 + ai * HALF + m * 16) * INW + col0;
#pragma unroll
                for (int bj = 0; bj < 2; ++bj) { const f32x4 v0 = acc[ai][bj][m][0] * sc, v1 = acc[ai][bj][m][1] * sc;
                    u32x4 w; w.x = cvt_pk_bf16(v0[0], v0[1]); w.y = cvt_pk_bf16(v0[2], v0[3]); w.z = cvt_pk_bf16(v1[0], v1[1]); w.w = cvt_pk_bf16(v1[2], v1[3]);
                    *(u32x4*)(rowp + bj * HALF) = w; } }
    }
};
struct EpiResid {
    static constexpr bool PERM = true;
    const float* xin32; const bf16_t* xin16; bf16_t* xout;
    __device__ __forceinline__ void init(f32x4 (&acc)[2][2][4][2], const Unit&, int, int) const {
#pragma unroll
        for (int a = 0; a < 2; ++a)
#pragma unroll
            for (int b = 0; b < 2; ++b)
#pragma unroll
                for (int m = 0; m < 4; ++m)
#pragma unroll
                    for (int n = 0; n < 2; ++n) acc[a][b][m][n] = (f32x4){0.f, 0.f, 0.f, 0.f};
    }
    __device__ __forceinline__ void operator()(const f32x4 (&acc)[2][2][4][2], const Unit& u, int wr, int wc, int fr, int fq) const {
        const int row0 = u.orow + wr * 64 + fr, col0 = u.ocol + wc * 32 + 8 * fq;
#define RES_OFF(bt, ml) ((size_t)(row0 + ((bt) >> 1) * HALF + (2 * ((bt) & 1) + (ml)) * 16) * D + col0)
        if (xin32) {
            f32x4 t[2][2][2][2];
#define RES_LD32(bt) do { _Pragma("unroll") for (int ml = 0; ml < 2; ++ml) _Pragma("unroll") for (int bj = 0; bj < 2; ++bj) { const float* p_ = xin32 + RES_OFF(bt, ml) + bj * HALF; \
                t[(bt) & 1][ml][bj][0] = *(const f32x4*)p_; t[(bt) & 1][ml][bj][1] = *(const f32x4*)(p_ + 4); } asm volatile("" ::: "memory"); } while (0)
            RES_LD32(0);
#pragma unroll
            for (int bt = 0; bt < 4; ++bt) {
                if (bt == 0) RES_LD32(1); else if (bt == 1) RES_LD32(2); else if (bt == 2) RES_LD32(3);
                const int ai = bt >> 1;
#pragma unroll
                for (int ml = 0; ml < 2; ++ml) { const int m = 2 * (bt & 1) + ml;
#pragma unroll
                    for (int bj = 0; bj < 2; ++bj) { const f32x4 v0 = t[bt & 1][ml][bj][0] + acc[ai][bj][m][0], v1 = t[bt & 1][ml][bj][1] + acc[ai][bj][m][1];
                        u32x4 w; w.x = cvt_pk_bf16(v0[0], v0[1]); w.y = cvt_pk_bf16(v0[2], v0[3]); w.z = cvt_pk_bf16(v1[0], v1[1]); w.w = cvt_pk_bf16(v1[2], v1[3]);
                        *(u32x4*)(xout + RES_OFF(bt, ml) + bj * HALF) = w; } }
                asm volatile("" ::: "memory");
            }
#undef RES_LD32
        } else {
            u32x4 t[2][2][2];
#define RES_LD16(bt) do { _Pragma("unroll") for (int ml = 0; ml < 2; ++ml) _Pragma("unroll") for (int bj = 0; bj < 2; ++bj) t[(bt) & 1][ml][bj] = *(const u32x4*)(xin16 + RES_OFF(bt, ml) + bj * HALF); \
                asm volatile("" ::: "memory"); } while (0)
            RES_LD16(0);
#pragma unroll
            for (int bt = 0; bt < 4; ++bt) {
                if (bt == 0) RES_LD16(1); else if (bt == 1) RES_LD16(2); else if (bt == 2) RES_LD16(3);
                const int ai = bt >> 1;
#pragma unroll
                for (int ml = 0; ml < 2; ++ml) { const int m = 2 * (bt & 1) + ml;
#pragma unroll
                    for (int bj = 0; bj < 2; ++bj) { const u32x4 b = t[bt & 1][ml][bj]; const f32x4 a0 = acc[ai][bj][m][0], a1 = acc[ai][bj][m][1];
                        u32x4 w; w.x = cvt_pk_bf16(a0[0] + __builtin_bit_cast(float, b.x << 16), a0[1] + __builtin_bit_cast(float, b.x & 0xffff0000u));
                        w.y = cvt_pk_bf16(a0[2] + __builtin_bit_cast(float, b.y << 16), a0[3] + __builtin_bit_cast(float, b.y & 0xffff0000u));
                        w.z = cvt_pk_bf16(a1[0] + __builtin_bit_cast(float, b.z << 16), a1[1] + __builtin_bit_cast(float, b.z & 0xffff0000u));
                        w.w = cvt_pk_bf16(a1[2] + __builtin_bit_cast(float, b.w << 16), a1[3] + __builtin_bit_cast(float, b.w & 0xffff0000u));
                        *(u32x4*)(xout + RES_OFF(bt, ml) + bj * HALF) = w; } }
                asm volatile("" ::: "memory");
            }
#undef RES_LD16
        }
#undef RES_OFF
    }
};
struct EpiSwiglu {
    static constexpr bool PERM = true;
    bf16_t* act; const float* bg; const float* bu;
    __device__ __forceinline__ void init(f32x4 (&acc)[2][2][4][2], const Unit& u, int wc, int fq) const {
        const int col0 = u.ocol + wc * 32 + 8 * fq;
#pragma unroll
        for (int n = 0; n < 2; ++n) { const f32x4 vg = *(const f32x4*)(bg + u.e * D + col0 + 4 * n) * (F8_SH * F8_SG), vu = (*(const f32x4*)(bu + u.e * D + col0 + 4 * n) + 1.0f) * (F8_SH * F8_SG);
#pragma unroll
            for (int ai = 0; ai < 2; ++ai)
#pragma unroll
                for (int m = 0; m < 4; ++m) { acc[ai][0][m][n] = vg; acc[ai][1][m][n] = vu; } }
    }
    __device__ __forceinline__ void operator()(const f32x4 (&acc)[2][2][4][2], const Unit& u, int wr, int wc, int fr, int fq) const {
        const int col0 = u.ocol + wc * 32 + 8 * fq;
#pragma unroll
        for (int ai = 0; ai < 2; ++ai)
#pragma unroll
            for (int m = 0; m < 4; ++m) { const int rl = ai * HALF + wr * 64 + m * 16 + fr;
                float o[8];
#pragma unroll
                for (int n = 0; n < 2; ++n) { f32x4 g, u1;
#pragma unroll
                    for (int i = 0; i < 4; ++i) { float g_, u_;
                        asm("v_min_f32 %0, %1, %2" : "=v"(g_) : "s"(7.0f * (F8_SH * F8_SG)), "v"(acc[ai][0][m][n][i]));
                        asm("v_med3_f32 %0, %1, %2, %3" : "=v"(u_) : "v"(acc[ai][1][m][n][i]), "s"(-6.0f * (F8_SH * F8_SG)), "v"(8.0f * (F8_SH * F8_SG))); g[i] = g_; u1[i] = u_; }
                    f32x4 e = g * (-1.702f * LOG2E / (F8_SH * F8_SG));
#pragma unroll
                    for (int i = 0; i < 4; ++i) e[i] = __builtin_amdgcn_exp2f(e[i]);
                    e = e + 1.0f;
#pragma unroll
                    for (int i = 0; i < 4; ++i) e[i] = __builtin_amdgcn_rcpf(e[i]);
                    const f32x4 r = u1 * (g * e) * (F8_SA / ((F8_SH * F8_SG) * (F8_SH * F8_SG)));
#pragma unroll
                    for (int i = 0; i < 4; ++i) o[4 * n + i] = r[i]; }
                if (rl < u.valid) { u32x2 w; w.x = pk4_fp8(o[0], o[1], o[2], o[3]); w.y = pk4_fp8(o[4], o[5], o[6], o[7]);
                    *(u32x2*)((unsigned char*)act + (size_t)(u.orow + rl) * D + col0) = w; } }
    }
};
struct EpiDown {
    static constexpr bool PERM = true;
    bf16_t* y; const float* bd; const u32x2* gs;
    __device__ __forceinline__ void init(f32x4 (&acc)[2][2][4][2], const Unit& u, int wc, int fq) const {
        const int col0 = u.ocol + wc * 32 + 8 * fq;
#pragma unroll
        for (int bj = 0; bj < 2; ++bj)
#pragma unroll
            for (int n = 0; n < 2; ++n) { const f32x4 bv = *(const f32x4*)(bd + u.e * D + col0 + bj * HALF + 4 * n) * (F8_SA * F8_SW);
#pragma unroll
                for (int ai = 0; ai < 2; ++ai)
#pragma unroll
                    for (int m = 0; m < 4; ++m) acc[ai][bj][m][n] = bv; }
    }
    __device__ __forceinline__ void operator()(const f32x4 (&acc)[2][2][4][2], const Unit& u, int wr, int wc, int fr_, int fq_) const {
        int fr = fr_, fq = fq_; asm volatile("" : "+v"(fr), "+v"(fq));
        const int col0 = u.ocol + wc * 32 + 8 * fq;
        u32x2 gtv[2][4];
#pragma unroll
        for (int ai = 0; ai < 2; ++ai)
#pragma unroll
            for (int m = 0; m < 4; ++m) { const int rl = ai * HALF + wr * 64 + m * 16 + fr; gtv[ai][m] = gs[u.grow + (rl < u.valid ? rl : 0)]; }
#pragma unroll
        for (int ai = 0; ai < 2; ++ai)
#pragma unroll
            for (int m = 0; m < 4; ++m) asm volatile("" : "+v"(gtv[ai][m].x), "+v"(gtv[ai][m].y) :: "memory");
#pragma unroll
        for (int ai = 0; ai < 2; ++ai)
#pragma unroll
            for (int m = 0; m < 4; ++m) { const int rl = ai * HALF + wr * 64 + m * 16 + fr;
                const float gt = __builtin_bit_cast(float, gtv[ai][m].x) * (F8_SY / (F8_SA * F8_SW)); unsigned char* rowp = (unsigned char*)y + (size_t)gtv[ai][m].y * D + col0;
                u32x2 w[2];
#pragma unroll
                for (int bj = 0; bj < 2; ++bj) { const f32x4 v0 = acc[ai][bj][m][0] * gt, v1 = acc[ai][bj][m][1] * gt;
                    w[bj].x = pk4_fp8(v0[0], v0[1], v0[2], v0[3]); w[bj].y = pk4_fp8(v1[0], v1[1], v1[2], v1[3]); }
                if (rl < u.valid) { *(u32x2*)(rowp) = w[0]; *(u32x2*)(rowp + HALF) = w[1]; } }
    }
};

template <class Epi, class Sched, bool GATHER = false, bool FP8 = false>
__device__ __forceinline__ void gemm_phase(LAS unsigned char* lds, const Gemm g, const Sched& S, const Epi& E) {
    int tid_ = threadIdx.x; asm volatile("" : "+v"(tid_));
    const int tid = tid_, wid = __builtin_amdgcn_readfirstlane(tid >> 6), lane = tid & 63, wr = wid >> 2, wc = wid & 3, fr = lane & 15, fq = lane >> 4;
    const int K = g.K, nt = K / BK;
    unsigned voffA[2], voffB[2], cA2[2]; int rA[2];
    unsigned gqc[2][2];
#pragma unroll
    for (int i = 0; i < 2; ++i) { int R, C; stage_rc(tid * 16 + i * 8192, R, C); const int Rb = Epi::PERM ? ((R & ~31) + perm32(R & 31)) : R;
        voffA[i] = (unsigned)(R * K + C) * 2u; voffB[i] = (unsigned)(Rb * K + C) * 2u; rA[i] = R; cA2[i] = (unsigned)C * 2u; }
    const size_t kstep = (size_t)(BK * 2);
    const size_t hstep = (size_t)HALF * K * 2;
    const size_t rstep = (size_t)K * 2;
    const unsigned ldsw = (unsigned)wid * 1024u;
    const int aoff = lds_byte(wr * 64 + fr, fq * 8), boff = lds_byte(wc * 32 + fr, fq * 8);
#define PG8_SA(b, h) (((b) * 2 + (h)) * HTB)
#define PG8_SB(b, h) ((4 + (b) * 2 + (h)) * HTB)
#define PG8_STAGE(bufoff, gbase, voff) do { _Pragma("unroll") for (int _i = 0; _i < 2; ++_i) \
        __builtin_amdgcn_global_load_lds((const unsigned*)((const char*)(gbase) + (voff)[_i]), (LAS unsigned*)(lds + (bufoff) + ldsw + _i * 8192), 16, 0, 0); } while (0)
#define PG8_STAGE_A(bufoff, ptr, h, kt, gq) do { if constexpr (GATHER) { const char* gb_ = (const char*)g.A + (size_t)(kt) * kstep; PG8_STAGE(bufoff, gb_, (gq)[h]); } else { PG8_STAGE(bufoff, (ptr) + (h) * hstep, voffA); } } while (0)
#define PG8_GLOAD(gq, uidx) do { _Pragma("unroll") for (int h_ = 0; h_ < 2; ++h_) _Pragma("unroll") for (int i_ = 0; i_ < 2; ++i_) { \
        const int tok_ = gtab[(uidx) * BM + h_ * HALF + rA[i_]]; (gq)[h_][i_] = (unsigned)tok_ * (unsigned)rstep + cA2[i_]; } } while (0)
#define PG8_LDA(dst, b, h) do { _Pragma("unroll") for (int m = 0; m < 4; ++m) _Pragma("unroll") for (int k = 0; k < 2; ++k) dst[m][k] = *(const LAS bf16x8*)(lds + PG8_SA(b, h) + aoff + m * 2048 + k * 1024); } while (0)
#define PG8_LDB(dst, b, h) do { _Pragma("unroll") for (int n = 0; n < 2; ++n) _Pragma("unroll") for (int k = 0; k < 2; ++k) dst[n][k] = *(const LAS bf16x8*)(lds + PG8_SB(b, h) + boff + n * 2048 + k * 1024); } while (0)
#define PG8_CAT(x0, x1) __builtin_bit_cast(i32x8, __builtin_shufflevector(x0, x1, 0, 1, 2, 3, 4, 5, 6, 7, 8, 9, 10, 11, 12, 13, 14, 15))
#define PG8_MMA(ai, bj, At, Bt) do { __builtin_amdgcn_s_setprio(1); if constexpr (FP8) { _Pragma("unroll") for (int m = 0; m < 4; ++m) _Pragma("unroll") for (int n = 0; n < 2; ++n) \
        { const i32x8 a8_ = PG8_CAT(Bt[n][0], Bt[n][1]), b8_ = PG8_CAT(At[m][0], At[m][1]); \
          asm volatile("v_mfma_scale_f32_16x16x128_f8f6f4 %0, %1, %2, %0, %3, %3 op_sel_hi:[0,0,0]" : "+v"(acc[ai][bj][m][n]) : "v"(a8_), "v"(b8_), "v"(f8one)); } } else { \
        _Pragma("unroll") for (int m = 0; m < 4; ++m) _Pragma("unroll") for (int n = 0; n < 2; ++n) _Pragma("unroll") for (int k = 0; k < 2; ++k) \
        acc[ai][bj][m][n] = __builtin_amdgcn_mfma_f32_16x16x32_bf16(Bt[n][k], At[m][k], acc[ai][bj][m][n], 0, 0, 0); } __builtin_amdgcn_s_setprio(0); } while (0)
#define PG8_WAIT_V(n) asm volatile("s_waitcnt vmcnt(" #n ")" ::: "memory")
#define PG8_WAIT_L(n) asm volatile("s_waitcnt lgkmcnt(" #n ")" ::: "memory")
#define PG8_BAR __builtin_amdgcn_s_barrier()
#define PG8_SCHED __builtin_amdgcn_sched_barrier(0)
    Unit cur, nxt; int ui = 0;
    if (!S.next(0, cur)) return;
    f32x4 acc[2][2][4][2];
    int f8one = 0x7f7f7f7f; asm volatile("" : "+v"(f8one));
    E.init(acc, cur, wc, fq);
    bf16x8 At[4][2], B0[2][2], B1[2][2];
    const char* cA = (const char*)g.A + (size_t)cur.arow * rstep; const char* cB = (const char*)g.Bt + (size_t)cur.brow * rstep;
    LAS int* gtab = (LAS int*)(lds + GTAB_OFF);
    if constexpr (GATHER) {
        Unit uu;
        for (int i = wid; i < GTAB_UNITS && S.next(i, uu); i += 8) {
            int tk[4];
#pragma unroll
            for (int q = 0; q < 4; ++q) { const int r = lane + 64 * q; tk[q] = g.tl[uu.grow + (r < uu.valid ? r : 0)]; }
#pragma unroll
            for (int q = 0; q < 4; ++q) gtab[i * BM + lane + 64 * q] = tk[q]; }
        asm volatile("s_waitcnt vmcnt(0) lgkmcnt(0)" ::: "memory"); __builtin_amdgcn_s_barrier(); asm volatile("" ::: "memory");
        PG8_GLOAD(gqc, 0);
    }
    PG8_STAGE(PG8_SB(0, 0), cB, voffB); PG8_STAGE(PG8_SB(0, 1), cB + hstep, voffB); PG8_STAGE_A(PG8_SA(0, 0), cA, 0, 0, gqc); PG8_STAGE_A(PG8_SA(0, 1), cA, 1, 0, gqc);
    if (wr == 1) PG8_BAR;
    PG8_WAIT_V(2); PG8_BAR;
    PG8_STAGE(PG8_SB(1, 0), cB + kstep, voffB); PG8_STAGE_A(PG8_SA(1, 0), cA + kstep, 0, 1, gqc); PG8_STAGE(PG8_SB(1, 1), cB + hstep + kstep, voffB);
    PG8_WAIT_V(6); PG8_BAR;
    for (;;) {
        const bool has_next = S.next(ui + 1, nxt);
        const char* nA = has_next ? (const char*)g.A + (size_t)nxt.arow * rstep : cA; const char* nB = has_next ? (const char*)g.Bt + (size_t)nxt.brow * rstep : cB;
        const int un = has_next ? ui + 1 : ui;
#pragma unroll 1
        for (int t = 0; t < nt; t += 2) {
            const bool last = (t == nt - 2);
            const char* a1 = cA + (size_t)(t + 1) * kstep;
            const char* a2 = last ? nA : cA + (size_t)(t + 2) * kstep; const char* b2 = last ? nB : cB + (size_t)(t + 2) * kstep;
            const char* a3 = a2 + kstep; const char* b3 = b2 + kstep;
            const int k2 = last ? 0 : t + 2;
            if constexpr (GATHER) { if (last) {
#pragma unroll
                for (int i_ = 0; i_ < 2; ++i_) gqc[0][i_] = (unsigned)gtab[un * BM + rA[i_]] * (unsigned)rstep + cA2[i_]; } }
            PG8_LDB(B0, 0, 0); PG8_LDB(B1, 0, 1); PG8_SCHED; PG8_LDA(At, 0, 0); PG8_STAGE_A(PG8_SA(1, 1), a1, 1, t + 1, gqc);
            if constexpr (GATHER) { if (last) {
#pragma unroll
                for (int i_ = 0; i_ < 2; ++i_) gqc[1][i_] = (unsigned)gtab[un * BM + HALF + rA[i_]] * (unsigned)rstep + cA2[i_]; } }
            PG8_WAIT_V(8); PG8_WAIT_L(0); PG8_BAR; PG8_MMA(0, 0, At, B0); PG8_MMA(0, 1, At, B1); PG8_BAR; PG8_SCHED;
            PG8_LDA(At, 0, 1); PG8_STAGE(PG8_SB(0, 0), b2, voffB); PG8_STAGE(PG8_SB(0, 1), b2 + hstep, voffB); PG8_STAGE_A(PG8_SA(0, 0), a2, 0, k2, gqc);
            PG8_WAIT_V(8); PG8_WAIT_L(0); PG8_BAR; PG8_MMA(1, 0, At, B0); PG8_MMA(1, 1, At, B1); PG8_BAR; PG8_SCHED;
            PG8_LDB(B0, 1, 0); PG8_LDB(B1, 1, 1); PG8_SCHED; PG8_LDA(At, 1, 0); PG8_STAGE_A(PG8_SA(0, 1), a2, 1, k2, gqc);
            PG8_WAIT_V(8); PG8_WAIT_L(0); PG8_BAR; PG8_MMA(0, 0, At, B0); PG8_MMA(0, 1, At, B1); PG8_BAR; PG8_SCHED;
            PG8_LDA(At, 1, 1); PG8_STAGE(PG8_SB(1, 0), b3, voffB); PG8_STAGE(PG8_SB(1, 1), b3 + hstep, voffB); PG8_STAGE_A(PG8_SA(1, 0), a3, 0, k2 + 1, gqc);
            PG8_WAIT_V(8); PG8_WAIT_L(0); PG8_BAR; PG8_MMA(1, 0, At, B0); PG8_MMA(1, 1, At, B1); PG8_BAR; PG8_SCHED;
        }
        if (wr == 0) PG8_BAR;
        E(acc, cur, wr, wc, fr, fq);
        if (!has_next) break;
        E.init(acc, nxt, wc, fq);
        cur = nxt; cA = nA; cB = nB; ++ui;
        if (wr == 1) PG8_BAR;
    }
    PG8_WAIT_V(0);
    PG8_BAR;
#undef PG8_SA
#undef PG8_CAT
#undef PG8_SB
#undef PG8_STAGE
#undef PG8_STAGE_A
#undef PG8_GLOAD
#undef PG8_LDA
#undef PG8_LDB
#undef PG8_MMA
#undef PG8_WAIT_V
#undef PG8_WAIT_L
#undef PG8_BAR
#undef PG8_SCHED
}
}

#define XB_TMO      128
#define XB_XCNT(j)  (256  + 64 * (j))
#define XB_XSUB(j)  (1280 + 64 * (j))
#define XB_XGEN(j)  (2304 + 64 * (j))
#define XB_TOP      3328
#define XB_TOPGEN   3392
#define XCD_BAR_WORDS 3456
#define XB_SPIN_CAP (1u << 18)
__device__ __forceinline__ unsigned xb_ld(unsigned* p)              { return __hip_atomic_load(p, __ATOMIC_RELAXED, __HIP_MEMORY_SCOPE_AGENT); }
__device__ __forceinline__ unsigned xb_add(unsigned* p, unsigned v) { return __hip_atomic_fetch_add(p, v, __ATOMIC_RELAXED, __HIP_MEMORY_SCOPE_AGENT); }
__device__ __forceinline__ unsigned xb_xcc_id() { return (unsigned)__builtin_amdgcn_s_getreg((3 << 11) | 20) & 0xFu; }
#define XB_SPIN(cond, bar) do { unsigned _sp = 0; while (cond) { __builtin_amdgcn_s_sleep(1); \
    if ((++_sp & 255u) == 0u) { if (xb_ld(&(bar)[XB_TMO])) break; if (_sp > XB_SPIN_CAP) { atomicAdd(&(bar)[XB_TMO], 1u); break; } } } } while (0)
struct XcdBarrier { unsigned* bar; unsigned x; volatile LAS unsigned* st; };
__device__ __forceinline__ XcdBarrier xcd_barrier_post(unsigned* bar, volatile LAS unsigned* st) {
    XcdBarrier b; b.bar = bar; b.x = xb_xcc_id(); b.st = st;
    if (threadIdx.x == 0) (void)xb_add(&bar[XB_XCNT(b.x)], 1u);
    return b;
}
__device__ __forceinline__ void xcd_barrier_complete(unsigned* bar, unsigned x, unsigned& nloc, unsigned& nx) {
    const unsigned G = gridDim.x * gridDim.y * gridDim.z;
    unsigned sum, cnt, mine, sp = 0u;
    for (;;) {
        sum = 0u; cnt = 0u; mine = 0u;
#pragma unroll
        for (unsigned j = 0; j < 16; ++j) { const unsigned c = xb_ld(&bar[XB_XCNT(j)]); sum += c; cnt += (c > 0u) ? 1u : 0u; mine = (j == x) ? c : mine; }
        if (sum == G) break;
        __builtin_amdgcn_s_sleep(1);
        if ((++sp & 255u) == 0u) { if (xb_ld(&bar[XB_TMO])) break; if (sp > XB_SPIN_CAP) { atomicAdd(&bar[XB_TMO], 1u); break; } }
    }
    nloc = mine > 0u ? mine : 1u; nx = cnt > 0u ? cnt : 1u;
}
__device__ __forceinline__ void xcd_barrier(const XcdBarrier& b) {
    asm volatile("s_waitcnt vmcnt(0)" ::: "memory");
    __syncthreads();
    if (threadIdx.x == 0) {
        unsigned* bar = b.bar;
        __builtin_amdgcn_s_waitcnt(0);
        unsigned nloc = b.st[0], nx = b.st[1];
        if (nloc == 0u) { xcd_barrier_complete(bar, b.x, nloc, nx); b.st[0] = nloc; b.st[1] = nx; }
        const unsigned old = xb_add(&bar[XB_XSUB(b.x)], 1u);
        const unsigned gen = old / nloc;
        if (old + 1u == (gen + 1u) * nloc) {
            __builtin_amdgcn_fence(__ATOMIC_RELEASE, "agent");
            asm volatile("s_waitcnt vmcnt(0)" ::: "memory");
            const unsigned og = xb_add(&bar[XB_TOP], 1u);
            const unsigned tg = og / nx;
            if (og + 1u == (tg + 1u) * nx) xb_add(&bar[XB_TOPGEN], 1u);
            else XB_SPIN(xb_ld(&bar[XB_TOPGEN]) == tg, bar);
            __builtin_amdgcn_fence(__ATOMIC_ACQUIRE, "agent");
            xb_add(&bar[XB_XGEN(b.x)], 1u);
            asm volatile("s_waitcnt vmcnt(0)" ::: "memory");
        } else {
            XB_SPIN(xb_ld(&bar[XB_XGEN(b.x)]) == gen, bar);
            __builtin_amdgcn_fence(__ATOMIC_ACQUIRE, "agent");
            asm volatile("s_waitcnt vmcnt(0)" ::: "memory");
        }
    }
    __syncthreads();
}

#define GRID_SYNC() do { XcdBarrier b_; b_.bar = (unsigned*)(kargs()->ws + WS_CTL) + CW_BAR; b_.x = xb_xcc_id(); b_.st = (volatile LAS unsigned*)((LAS unsigned char*)lds + MISC_OFF) + 8; xcd_barrier(b_); } while (0)
struct Frame {
    LAS unsigned char* lds; unsigned char* ldsg;
    int tid, lane, wave, vcu, G;
};
__device__ __forceinline__ int opaque_tid() { int t = threadIdx.x; asm volatile("" : "+v"(t)); return t; }
__device__ __forceinline__ Frame refresh(const Frame& Fi) { Frame F; F.lds = Fi.lds; F.ldsg = Fi.ldsg; F.tid = opaque_tid(); F.lane = F.tid & 63; F.wave = __builtin_amdgcn_readfirstlane(F.tid >> 6);
    int g = (int)gridDim.x, bx = (int)blockIdx.x; asm volatile("" : "+s"(g), "+s"(bx)); F.G = g; F.vcu = (g % 8 == 0) ? (bx % 8) * (g / 8) + bx / 8 : bx; return F; }
__device__ __forceinline__ float wave_sum(float v) {
#pragma unroll
    for (int o = 1; o < 64; o <<= 1) v += __shfl_xor(v, o);
    return v;
}
__device__ __forceinline__ void transpose_item(const float* W, int K, int N, bf16_t* WT, int row_off, LAS float* scr, int k0, int n0, int lane) {
    { const int r8 = lane >> 3, c4 = (lane & 7) * 4;
      f32x4 v[8];
#pragma unroll
      for (int i = 0; i < 8; ++i) v[i] = *(const GAS f32x4*)(W + (size_t)(k0 + 8 * i + r8) * N + n0 + c4);
#pragma unroll
      for (int i = 0; i < 8; ++i) { LAS float* d = scr + (8 * i + r8) * 33 + c4; d[0] = v[i].x; d[1] = v[i].y; d[2] = v[i].z; d[3] = v[i].w; } }
    LDS_WAIT(); asm volatile("" ::: "memory");
    const int c = lane & 7;
#pragma unroll
    for (int j = 0; j < 4; ++j) { const int n = (lane >> 3) + 8 * j; const LAS float* s = scr + (8 * c) * 33 + n;
        u32x4 o; o.x = pk2(s[0 * 33], s[1 * 33]); o.y = pk2(s[2 * 33], s[3 * 33]); o.z = pk2(s[4 * 33], s[5 * 33]); o.w = pk2(s[6 * 33], s[7 * 33]);
        *(GAS u32x4*)(WT + (size_t)(row_off + n0 + n) * K + k0 + 8 * c) = o; }
    LDS_WAIT(); asm volatile("" ::: "memory");
}
__device__ __forceinline__ void transpose_item_f8(const float* W, int K, int N, unsigned char* WT, int row_off, float scale, LAS float* scr, int k0, int n0, int lane) {
    { const int r8 = lane >> 3, c4 = (lane & 7) * 4;
      f32x4 v[8];
#pragma unroll
      for (int i = 0; i < 8; ++i) v[i] = *(const GAS f32x4*)(W + (size_t)(k0 + 8 * i + r8) * N + n0 + c4);
#pragma unroll
      for (int i = 0; i < 8; ++i) { LAS float* d = scr + (8 * i + r8) * 33 + c4; d[0] = v[i].x * scale; d[1] = v[i].y * scale; d[2] = v[i].z * scale; d[3] = v[i].w * scale; } }
    LDS_WAIT(); asm volatile("" ::: "memory");
    const int c = lane & 7;
#pragma unroll
    for (int j = 0; j < 4; ++j) { const int n = (lane >> 3) + 8 * j; const LAS float* s = scr + (8 * c) * 33 + n;
        u32x2 o; o.x = pk4_fp8(s[0 * 33], s[1 * 33], s[2 * 33], s[3 * 33]); o.y = pk4_fp8(s[4 * 33], s[5 * 33], s[6 * 33], s[7 * 33]);
        *(GAS u32x2*)(WT + (size_t)(row_off + n0 + n) * K + k0 + 8 * c) = o; }
    LDS_WAIT(); asm volatile("" ::: "memory");
}
__device__ __forceinline__ void convert_experts(const Frame& Fi, const float* wg, const float* wu, const float* wd, bf16_t* WGU, bf16_t* WDN) {
    Frame F = refresh(Fi);
    LAS float* scr = (LAS float*)(F.lds + F.wave * 16384);
    const int gw = F.vcu * NWAVES + F.wave, NGW = F.G * NWAVES;
    constexpr int IPM = (D / 64) * (D / 32);
    for (int it = gw; it < NE * 3 * IPM; it += NGW) {
        const int e = it / (3 * IPM), r = it % (3 * IPM), which = r / IPM, q = r % IPM, kb = q / (D / 32), nb = q % (D / 32), k0 = 64 * kb, n0 = 32 * nb;
        if (which == 2) transpose_item_f8(wd + (size_t)e * D * D, D, D, (unsigned char*)WDN + (size_t)e * D * D, 0, pg8::F8_SW, scr, k0, n0, F.lane);
        else { const int pn = n0 >> 7, dst0 = pn * 256 + which * 128 + (n0 & 127);
            transpose_item_f8((which ? wu : wg) + (size_t)e * D * D, D, D, (unsigned char*)WGU + (size_t)e * 2 * D * D, dst0 - n0, pg8::F8_SG, scr, k0, n0, F.lane); }
    }
}
__device__ __forceinline__ void load_row(const float* xrow, int lane, f32x4 (&v)[4]) {
    const GAS f32x4* xr = (const GAS f32x4*)xrow + lane;
#pragma unroll
    for (int j = 0; j < 4; ++j) v[j] = xr[64 * j];
}
__device__ __forceinline__ void load_row16(const bf16_t* xrow, int lane, u32x2 (&v)[4]) {
    const GAS u32x2* xr = (const GAS u32x2*)xrow + lane;
#pragma unroll
    for (int j = 0; j < 4; ++j) v[j] = xr[64 * j];
}
__device__ __forceinline__ f32x4 up4(const u32x2 w) { return (f32x4){__builtin_bit_cast(float, w.x << 16), __builtin_bit_cast(float, w.x & 0xffff0000u), __builtin_bit_cast(float, w.y << 16), __builtin_bit_cast(float, w.y & 0xffff0000u)}; }
__device__ __forceinline__ float row_rstd(const f32x4 (&v)[4]) {
    float s = 0.f;
#pragma unroll
    for (int j = 0; j < 4; ++j) s += (v[j].x * v[j].x + v[j].y * v[j].y) + (v[j].z * v[j].z + v[j].w * v[j].w);
    return 1.0f / sqrtf(wave_sum(s) * (1.f / D) + EPS);
}
__device__ __forceinline__ void load_gain(const float* gain, int lane, f32x4 (&g)[4]) {
#pragma unroll
    for (int j = 0; j < 4; ++j) g[j] = *((const GAS f32x4*)gain + lane + 64 * j);
}
__device__ __forceinline__ void store_row_bf16(bf16_t* orow, int lane, const f32x4 (&v)[4], const f32x4 (&g)[4], float rstd) {
    GAS unsigned long long* o8 = (GAS unsigned long long*)orow + lane;
#pragma unroll
    for (int j = 0; j < 4; ++j)
        o8[64 * j] = (unsigned long long)pk2(v[j].x * rstd * g[j].x, v[j].y * rstd * g[j].y) | ((unsigned long long)pk2(v[j].z * rstd * g[j].z, v[j].w * rstd * g[j].w) << 32);
}

__device__ __forceinline__ void vt_phase(const Frame& Fi, const bf16_t* qkvp, unsigned char* vt) {
    Frame F = refresh(Fi);
    const int lane = F.lane;
    LAS unsigned char* scr = F.lds + F.wave * 16384;
    for (int tile = F.vcu * NWAVES + F.wave; tile < BATCH * NH * (SEQ / 64); tile += F.G * NWAVES) {
        const int bh = tile >> 7, t = tile & 127, b = bh >> 2, h = bh & 3;
        const bf16_t* src = qkvp + ((size_t)b * SEQ + 64 * t) * INW + 1024 + h * 128;
        unsigned char* dst = vt + (size_t)tile * 8192;
#pragma unroll 1
        for (int part = 0; part < 2; ++part) {
            u32x4 v[8];
#pragma unroll
            for (int i = 0; i < 8; ++i) { const int pc = lane + 64 * i; v[i] = *(const u32x4*)(src + (size_t)(32 * part + (pc >> 4)) * INW + (pc & 15) * 8); }
#pragma unroll
            for (int i = 0; i < 8; ++i) { const int pc = lane + 64 * i; *(LAS u32x4*)(scr + (pc >> 4) * 272 + (pc & 15) * 16) = v[i]; }
            LDS_WAIT(); asm volatile("" ::: "memory");
#pragma unroll
            for (int dd = 0; dd < 2; ++dd) { const int dv = lane + 64 * dd; unsigned wd[8];
#pragma unroll
                for (int g = 0; g < 8; ++g) { float f[4];
#pragma unroll
                    for (int j = 0; j < 4; ++j) f[j] = __builtin_bit_cast(float, (unsigned)(*(const LAS unsigned short*)(scr + (4 * g + j) * 272 + dv * 2)) << 16) * 16.0f;
                    wd[g] = pk4_fp8(f[0], f[1], f[2], f[3]); }
                const int sw = (dv >> 2) & 3;
                *(u32x4*)(dst + dv * 64 + (((0 + part) ^ sw) << 4)) = (u32x4){wd[0], wd[2], wd[4], wd[6]};
                *(u32x4*)(dst + dv * 64 + (((2 + part) ^ sw) << 4)) = (u32x4){wd[1], wd[3], wd[5], wd[7]}; }
            LDS_WAIT(); asm volatile("" ::: "memory");
        }
    }
}

namespace att {
constexpr int PITCH = INW, NT = SEQ / 64, SLOTB = 32768, VOFF = 16384;
constexpr int L_V = 65536, L_ONES = 98304, L_LUT = 100352, L_WSF = 102400, L_STG = 65536;
constexpr float THR = 8.0f;
__device__ __forceinline__ int crow(int r, int hi) { return (r & 3) + 8 * (r >> 2) + 4 * hi; }
__device__ __forceinline__ void glds16(const void* sbase, unsigned voff, unsigned lds_dst) { unsigned keep;
    asm volatile("s_mov_b32 %0, m0\n\ts_mov_b32 m0, %3\n\ts_nop 0\n\tglobal_load_lds_dwordx4 %1, %2\n\ts_mov_b32 m0, %0" : "=&s"(keep) : "v"(voff), "s"(sbase), "s"(lds_dst) : "memory"); }
#define ATT_WAIT_BAR() asm volatile("s_waitcnt vmcnt(0) lgkmcnt(0)\n\ts_barrier" ::: "memory")
#define ATT_BAR() asm volatile("s_waitcnt lgkmcnt(0)\n\ts_barrier" ::: "memory")
__device__ __forceinline__ s16x4 vtr(const LAS char* p) { return __builtin_bit_cast(s16x4, __builtin_amdgcn_ds_read_tr16_b64_v4i16((LAS s16x4*)p)); }
__device__ __forceinline__ int rel_bucket(int rel) {
    const int ret = rel > 0 ? 16 : 0; const int n = rel < 0 ? -rel : rel;
    if (n < 8) return ret + n;
    int j = 0; while (j < 7 && 64 * (2 << j) <= n * n) ++j;
    return ret + 8 + j;
}
__device__ __forceinline__ void qkt(f32x16& p0, f32x16& p1, const LAS char* kb, const bf16x8 (&qr)[4], const f32x16& cin) {
#pragma unroll
    for (int d0 = 0; d0 < 4; ++d0) {
        const bf16x8 b0 = *(const LAS bf16x8*)(kb + d0 * 2048);
        const bf16x8 b1 = *(const LAS bf16x8*)(kb + d0 * 2048 + 512);
        if (d0 == 0) { p0 = __builtin_amdgcn_mfma_f32_32x32x16_bf16(b0, qr[0], cin, 0, 0, 0); p1 = __builtin_amdgcn_mfma_f32_32x32x16_bf16(b1, qr[0], cin, 0, 0, 0); }
        else { p0 = __builtin_amdgcn_mfma_f32_32x32x16_bf16(b0, qr[d0], p0, 0, 0, 0); p1 = __builtin_amdgcn_mfma_f32_32x32x16_bf16(b1, qr[d0], p1, 0, 0, 0); }
    }
}
#define MX3(a, b, c) __builtin_fmaxf(__builtin_fmaxf((a), (b)), (c))
__device__ __forceinline__ float rowmax(const f32x16& p0, const f32x16& p1) {
    float a = MX3(p0[0], p0[1], p1[0]), b = MX3(p0[2], p0[3], p1[1]); a = MX3(a, p1[2], p1[3]);
#pragma unroll
    for (int r = 4; r < 16; r += 4) { a = MX3(a, p0[r], p0[r + 1]); b = MX3(b, p0[r + 2], p0[r + 3]); a = MX3(a, p1[r], p1[r + 1]); b = MX3(b, p1[r + 2], p1[r + 3]); }
    float rm = __builtin_fmaxf(a, b);
    auto rr = __builtin_amdgcn_permlane32_swap(__float_as_uint(rm), __float_as_uint(rm), false, false);
    return __builtin_fmaxf(__uint_as_float(rr[0]), __uint_as_float(rr[1]));
}
__device__ __forceinline__ void attn_unit(int b, int h, int qb, const bf16_t* __restrict__ qkvp, const unsigned char* __restrict__ vt, bf16_t* mix, unsigned char* shm, const float* rel_table, float lam, const float* subg, float oscale) {
    int tid_ = threadIdx.x; asm volatile("" : "+v"(tid_));
    const int tid = tid_, lane = tid & 63, r32 = lane & 31, hi = lane >> 5;
    const int wid = __builtin_amdgcn_readfirstlane(tid >> 6), wq = wid >> 1, mp = wid & 1;
    const long rowbase = (long)b * SEQ; const int q0 = qb * 128;
    const unsigned lds0 = (unsigned)(uintptr_t)shm;
    LAS unsigned char* shm3 = (LAS unsigned char*)shm;
    LAS float* lut = (LAS float*)(shm3 + L_LUT);
    LAS float* wsf = (LAS float*)(shm3 + L_WSF) + wid * 64;
    const float lutv = rel_table[rel_bucket(min(tid, 446) - 223) * NH + h];
    const float cL = rel_table[15 * NH + h] * LOG2E, cR = rel_table[31 * NH + h] * LOG2E;
    const bf16_t* Qw = qkvp + (rowbase + q0 + wq * 32 + r32) * PITCH + h * 128 + mp * 64;
    bf16x8 qr[4];
#pragma unroll
    for (int d0 = 0; d0 < 4; ++d0) qr[d0] = *(const bf16x8*)(Qw + d0 * 16 + hi * 8);
    const bf16_t* ksrc = qkvp + rowbase * PITCH + 512 + h * 128 + wid * 8;
    const unsigned char* vsrc = vt + (size_t)((b * NH + h) * NT) * 8192 + wid * 1024;
    const unsigned kvo = (unsigned)lane * PITCH * 2u, vvo = (unsigned)lane * 16u;
    const unsigned dst0 = lds0 + wid * 1024;
#define ATT_ISSUE_K(t) do { const bf16_t* ks_ = ksrc + (long)(t) * 64 * PITCH; const unsigned d_ = (unsigned)__builtin_amdgcn_readfirstlane(dst0 + ((t) & 3) * 16384); glds16(ks_, kvo, d_); glds16(ks_ + 64, kvo, d_ + 8192); } while (0)
#define ATT_ISSUE_K1(t, pc) do { const bf16_t* ks_ = ksrc + (long)(t) * 64 * PITCH + (pc) * 64; const unsigned d_ = (unsigned)__builtin_amdgcn_readfirstlane(dst0 + ((t) & 3) * 16384 + (pc) * 8192); glds16(ks_, kvo, d_); } while (0)
#define ATT_ISSUE_V1(t, pc) do { if ((pc) == 0) { const unsigned char* vs_ = vsrc + (size_t)(t) * 8192; const unsigned d_ = (unsigned)__builtin_amdgcn_readfirstlane(dst0 + L_V + ((t) & 3) * 8192); glds16(vs_, vvo, d_); } } while (0)
#define ATT_ISSUE_V(t) ATT_ISSUE_V1(t, 0)
    const LAS char* kp0 = (const LAS char*)shm3 + mp * 8192 + hi * 1024 + r32 * 16;
    const LAS char* vp0 = (const LAS char*)shm3 + L_V + r32 * 64 + (((2 * hi) ^ ((r32 >> 2) & 3)) << 4);
    const LAS char* vq0 = (const LAS char*)shm3 + L_V + r32 * 64 + (((2 * hi + 1) ^ ((r32 >> 2) & 3)) << 4);
    const LAS char* vo0 = (const LAS char*)shm3 + L_ONES + r32 * 64;
    f32x16 o[5];
#pragma unroll
    for (int d = 0; d < 5; ++d)
#pragma unroll
        for (int r = 0; r < 16; ++r) o[d][r] = 0.f;
    float m_run = 0.f;
    const int qlo = q0 + wq * 32, qq = qlo + r32;
    f32x16 negm;
    float ct_cur;
    bool resc;
#define ATT_CLASS(t) ((64 * (t) + 63 - qlo <= -128) ? 0 : ((64 * (t) - (qlo + 31) >= 128) ? 2 : 1))
#define ATT_LUTADD(S0, S1, t) do { asm volatile("" ::: "memory");     \
        const LAS float* lb_ = lut + (64 * (t) + 4 * hi - qq + 223);          \
        _Pragma("unroll") for (int r = 0; r < 16; ++r) { S0[r] += lb_[(r & 3) + 8 * (r >> 2)]; S1[r] += lb_[(r & 3) + 8 * (r >> 2) + 32]; } } while (0)
#define SBAR() __builtin_amdgcn_sched_barrier(0)
#define ATT_VRD8(d) do { if ((d) == 4) { vf8[0][0] = *(const LAS u32x4*)(vo0); vf8[0][1] = *(const LAS u32x4*)(vo0 + 16); } else { vf8[(d) & 1][0] = *(const LAS u32x4*)(vp_ + (d) * 2048); vf8[(d) & 1][1] = *(const LAS u32x4*)(vq_ + (d) * 2048); } } while (0)
#define ATT_CAT8(x0, x1) __builtin_bit_cast(i32x8, __builtin_shufflevector(x0, x1, 0, 1, 2, 3, 4, 5, 6, 7))
#define ATT_PV8(d) do { const i32x8 a8_ = ATT_CAT8(p8a, p8b), b8_ = ATT_CAT8(vf8[(d) & 1][0], vf8[(d) & 1][1]); \
        asm volatile("v_mfma_scale_f32_32x32x64_f8f6f4 %0, %1, %2, %0, %3, %3 op_sel_hi:[0,0,0]" : "+v"(o[d]) : "v"(a8_), "v"(b8_), "v"(f8one)); } while (0)
#define ATT_KRD(j) do { kfr[(j) % 3] = *(const LAS bf16x8*)(kq_ + ((j) >> 1) * 2048 + ((j) & 1) * 512); } while (0)
#define ATT_STEP(C0, C1, N0, N1, t, HASQK, FIRST) do { \
        const int cls_ = ATT_CLASS((t) + 1); const float ctn_ = cls_ == 0 ? cL : (cls_ == 2 ? cR : 0.f); \
        if (HASQK) { if (ctn_ != ct_cur) { asm volatile("" ::: "memory"); const float cm_ = ctn_ - m_run;     \
            _Pragma("unroll") for (int r = 0; r < 16; ++r) negm[r] = cm_; \
            ct_cur = ctn_; } } \
        const LAS char* kq_ = kp0 + (((t) + 1) & 3) * 16384; const LAS char* vp_ = vp0 + (((t) - 1) & 3) * 8192; const LAS char* vq_ = vq0 + (((t) - 1) & 3) * 8192; \
        float ra_ = 0.f, rb_ = 0.f; \
        ATT_VRD8(0); ATT_VRD8(1); if (HASQK) { ATT_KRD(0); ATT_KRD(1); } \
        __builtin_amdgcn_s_setprio(1); SBAR(); \
        ATT_PV8(0); ATT_VRD8(2); C0[0] = __builtin_amdgcn_exp2f(C0[0]); C0[1] = __builtin_amdgcn_exp2f(C0[1]); asm volatile("" : "+v"(C0[0])); asm volatile("" : "+v"(C0[1])); if (FIRST) { if ((t) + 3 < NT) ATT_ISSUE_K1((t) + 3, 0); } SBAR(); \
        if (HASQK) { N0 = __builtin_amdgcn_mfma_f32_32x32x16_bf16(kfr[0], qr[0], negm, 0, 0, 0); ATT_KRD(2); } SBAR(); \
        ATT_PV8(1); ATT_VRD8(3); C0[2] = __builtin_amdgcn_exp2f(C0[2]); C0[3] = __builtin_amdgcn_exp2f(C0[3]); asm volatile("" : "+v"(C0[2])); asm volatile("" : "+v"(C0[3])); if (FIRST) { if ((t) + 1 < NT) ATT_ISSUE_V1((t) + 1, 0); } SBAR(); \
        if (HASQK) { N1 = __builtin_amdgcn_mfma_f32_32x32x16_bf16(kfr[1], qr[0], negm, 0, 0, 0); ATT_KRD(3); } SBAR(); \
        ATT_PV8(2); ATT_VRD8(4); C0[4] = __builtin_amdgcn_exp2f(C0[4]); C0[5] = __builtin_amdgcn_exp2f(C0[5]); asm volatile("" : "+v"(C0[4])); asm volatile("" : "+v"(C0[5])); if (FIRST) { if ((t) + 3 < NT) ATT_ISSUE_K1((t) + 3, 1); } SBAR(); \
        if (HASQK) { N0 = __builtin_amdgcn_mfma_f32_32x32x16_bf16(kfr[2], qr[1], N0, 0, 0, 0); ATT_KRD(4); } SBAR(); \
        ATT_PV8(3); ATT_PV8(4); C0[6] = __builtin_amdgcn_exp2f(C0[6]); C0[7] = __builtin_amdgcn_exp2f(C0[7]); asm volatile("" : "+v"(C0[6])); asm volatile("" : "+v"(C0[7]));  if (FIRST) { if ((t) + 4 < NT) ATT_ISSUE_K1((t) + 4, 0); } SBAR(); \
        if (HASQK) { N1 = __builtin_amdgcn_mfma_f32_32x32x16_bf16(kfr[0], qr[1], N1, 0, 0, 0); ATT_KRD(5); } if (FIRST) { if ((t) + 4 < NT) ATT_ISSUE_K1((t) + 4, 1); } SBAR(); \
        C0[8] = __builtin_amdgcn_exp2f(C0[8]); C0[9] = __builtin_amdgcn_exp2f(C0[9]); asm volatile("" : "+v"(C0[8])); asm volatile("" : "+v"(C0[9])); p8a[0] = (unsigned)__builtin_amdgcn_cvt_pk_fp8_f32(C0[0], C0[1], (int)p8a[0], false); SBAR(); \
        if (HASQK) { N0 = __builtin_amdgcn_mfma_f32_32x32x16_bf16(kfr[1], qr[2], N0, 0, 0, 0); ATT_KRD(6); } if (FIRST) { if ((t) + 2 < NT) ATT_ISSUE_V1((t) + 2, 0); } SBAR(); \
        C0[10] = __builtin_amdgcn_exp2f(C0[10]); C0[11] = __builtin_amdgcn_exp2f(C0[11]); asm volatile("" : "+v"(C0[10])); asm volatile("" : "+v"(C0[11])); p8a[0] = (unsigned)__builtin_amdgcn_cvt_pk_fp8_f32(C0[2], C0[3], (int)p8a[0], true); SBAR(); \
        if (HASQK) { N1 = __builtin_amdgcn_mfma_f32_32x32x16_bf16(kfr[2], qr[2], N1, 0, 0, 0); ATT_KRD(7); } SBAR(); \
        C0[12] = __builtin_amdgcn_exp2f(C0[12]); C0[13] = __builtin_amdgcn_exp2f(C0[13]); asm volatile("" : "+v"(C0[12])); asm volatile("" : "+v"(C0[13])); p8a[1] = (unsigned)__builtin_amdgcn_cvt_pk_fp8_f32(C0[4], C0[5], (int)p8a[1], false); SBAR(); \
        if (HASQK) { N0 = __builtin_amdgcn_mfma_f32_32x32x16_bf16(kfr[0], qr[3], N0, 0, 0, 0); } SBAR(); \
        C0[14] = __builtin_amdgcn_exp2f(C0[14]); C0[15] = __builtin_amdgcn_exp2f(C0[15]); asm volatile("" : "+v"(C0[14])); asm volatile("" : "+v"(C0[15])); p8a[1] = (unsigned)__builtin_amdgcn_cvt_pk_fp8_f32(C0[6], C0[7], (int)p8a[1], true); SBAR(); \
        if (HASQK) { N1 = __builtin_amdgcn_mfma_f32_32x32x16_bf16(kfr[1], qr[3], N1, 0, 0, 0); } __builtin_amdgcn_s_setprio(0); SBAR(); \
        if (HASQK) { if (cls_ == 1) ATT_LUTADD(N0, N1, (t) + 1); } SBAR(); \
        C1[0] = __builtin_amdgcn_exp2f(C1[0]); C1[1] = __builtin_amdgcn_exp2f(C1[1]); asm volatile("" : "+v"(C1[0])); asm volatile("" : "+v"(C1[1])); p8a[2] = (unsigned)__builtin_amdgcn_cvt_pk_fp8_f32(C0[8], C0[9], (int)p8a[2], false); if (HASQK) { ra_ = MX3(N0[0], N0[1], N1[0]); } if (HASQK) { rb_ = MX3(N0[2], N0[3], N1[1]); } if (HASQK) { asm volatile("" : "+v"(ra_), "+v"(rb_)); } SBAR(); \
        C1[2] = __builtin_amdgcn_exp2f(C1[2]); C1[3] = __builtin_amdgcn_exp2f(C1[3]); asm volatile("" : "+v"(C1[2])); asm volatile("" : "+v"(C1[3])); p8a[2] = (unsigned)__builtin_amdgcn_cvt_pk_fp8_f32(C0[10], C0[11], (int)p8a[2], true); if (HASQK) { ra_ = MX3(ra_, N1[2], N1[3]); } if (HASQK) { ra_ = MX3(ra_, N0[4], N0[5]); } if (HASQK) { asm volatile("" : "+v"(ra_), "+v"(rb_)); } SBAR(); \
        C1[4] = __builtin_amdgcn_exp2f(C1[4]); C1[5] = __builtin_amdgcn_exp2f(C1[5]); asm volatile("" : "+v"(C1[4])); asm volatile("" : "+v"(C1[5])); p8a[3] = (unsigned)__builtin_amdgcn_cvt_pk_fp8_f32(C0[12], C0[13], (int)p8a[3], false); if (HASQK) { rb_ = MX3(rb_, N0[6], N0[7]); } if (HASQK) { ra_ = MX3(ra_, N1[4], N1[5]); } if (HASQK) { asm volatile("" : "+v"(ra_), "+v"(rb_)); } SBAR(); \
        C1[6] = __builtin_amdgcn_exp2f(C1[6]); C1[7] = __builtin_amdgcn_exp2f(C1[7]); asm volatile("" : "+v"(C1[6])); asm volatile("" : "+v"(C1[7])); p8a[3] = (unsigned)__builtin_amdgcn_cvt_pk_fp8_f32(C0[14], C0[15], (int)p8a[3], true); if (HASQK) { rb_ = MX3(rb_, N1[6], N1[7]); } if (HASQK) { ra_ = MX3(ra_, N0[8], N0[9]); } if (HASQK) { asm volatile("" : "+v"(ra_), "+v"(rb_)); } SBAR(); \
        C1[8] = __builtin_amdgcn_exp2f(C1[8]); C1[9] = __builtin_amdgcn_exp2f(C1[9]); asm volatile("" : "+v"(C1[8])); asm volatile("" : "+v"(C1[9])); p8b[0] = (unsigned)__builtin_amdgcn_cvt_pk_fp8_f32(C1[0], C1[1], (int)p8b[0], false); if (HASQK) { rb_ = MX3(rb_, N0[10], N0[11]); } if (HASQK) { ra_ = MX3(ra_, N1[8], N1[9]); } if (HASQK) { asm volatile("" : "+v"(ra_), "+v"(rb_)); } SBAR(); \
        C1[10] = __builtin_amdgcn_exp2f(C1[10]); C1[11] = __builtin_amdgcn_exp2f(C1[11]); asm volatile("" : "+v"(C1[10])); asm volatile("" : "+v"(C1[11])); p8b[0] = (unsigned)__builtin_amdgcn_cvt_pk_fp8_f32(C1[2], C1[3], (int)p8b[0], true); if (HASQK) { rb_ = MX3(rb_, N1[10], N1[11]); } if (HASQK) { ra_ = MX3(ra_, N0[12], N0[13]); } if (HASQK) { asm volatile("" : "+v"(ra_), "+v"(rb_)); } SBAR(); \
        C1[12] = __builtin_amdgcn_exp2f(C1[12]); C1[13] = __builtin_amdgcn_exp2f(C1[13]); asm volatile("" : "+v"(C1[12])); asm volatile("" : "+v"(C1[13])); p8b[1] = (unsigned)__builtin_amdgcn_cvt_pk_fp8_f32(C1[4], C1[5], (int)p8b[1], false); if (HASQK) { rb_ = MX3(rb_, N0[14], N0[15]); } if (HASQK) { ra_ = MX3(ra_, N1[12], N1[13]); } if (HASQK) { asm volatile("" : "+v"(ra_), "+v"(rb_)); } SBAR(); \
        C1[14] = __builtin_amdgcn_exp2f(C1[14]); C1[15] = __builtin_amdgcn_exp2f(C1[15]); asm volatile("" : "+v"(C1[14])); asm volatile("" : "+v"(C1[15])); p8b[1] = (unsigned)__builtin_amdgcn_cvt_pk_fp8_f32(C1[6], C1[7], (int)p8b[1], true); if (HASQK) { rb_ = MX3(rb_, N1[14], N1[15]); } if (HASQK) { asm volatile("" : "+v"(ra_), "+v"(rb_)); } SBAR(); \
        p8b[2] = (unsigned)__builtin_amdgcn_cvt_pk_fp8_f32(C1[8], C1[9], (int)p8b[2], false); p8b[2] = (unsigned)__builtin_amdgcn_cvt_pk_fp8_f32(C1[10], C1[11], (int)p8b[2], true); p8b[3] = (unsigned)__builtin_amdgcn_cvt_pk_fp8_f32(C1[12], C1[13], (int)p8b[3], false); p8b[3] = (unsigned)__builtin_amdgcn_cvt_pk_fp8_f32(C1[14], C1[15], (int)p8b[3], true); \
        if (resc) { LDS_WAIT(); \
            _Pragma("unroll") for (int r = 0; r < 16; ++r) { const float fr_ = wsf[crow(r, hi)]; \
                _Pragma("unroll") for (int d = 0; d < 5; ++d) o[d][r] *= fr_; } } \
        resc = false; \
        if (HASQK) { float rm_ = __builtin_fmaxf(ra_, rb_); \
            { auto rr_ = __builtin_amdgcn_permlane32_swap(__float_as_uint(rm_), __float_as_uint(rm_), false, false); rm_ = __builtin_fmaxf(__uint_as_float(rr_[0]), __uint_as_float(rr_[1])); } \
            if (__any(rm_ > THR)) { const float dl_ = __builtin_fmaxf(rm_, 0.f); m_run += dl_; \
                _Pragma("unroll") for (int r = 0; r < 16; ++r) { N0[r] -= dl_; N1[r] -= dl_; negm[r] -= dl_; } \
                const float f_ = __builtin_amdgcn_exp2f(-dl_); if (hi == 0) wsf[r32] = f_; resc = true; } } \
    } while (0)
    int f8one = 0x7f7f7f7f; asm volatile("" : "+v"(f8one));
    f32x16 sA0, sA1, sB0, sB1; u32x4 p8a, p8b, vf8[2][2]; bf16x8 kfr[3];
    ATT_ISSUE_K(0); ATT_ISSUE_K(1);
    if (tid < 447) lut[tid] = lutv * LOG2E;
    if (tid < 128) { unsigned fill = (tid < 4) ? 0x38383838u : 0u; asm volatile("" : "+v"(fill));
        *(LAS u32x4*)(shm3 + L_ONES + tid * 16) = (u32x4){fill, fill, fill, fill}; }
    ATT_WAIT_BAR();
    ATT_ISSUE_K(2); ATT_ISSUE_K(3); ATT_ISSUE_V(0); ATT_ISSUE_V(1);
    {
        const int cls = ATT_CLASS(0); ct_cur = cls == 0 ? cL : (cls == 2 ? cR : 0.f);
#pragma unroll
        for (int r = 0; r < 16; ++r) negm[r] = ct_cur;
        qkt(sA0, sA1, kp0, qr, negm);
        if (cls == 1) ATT_LUTADD(sA0, sA1, 0);
        const float rm = rowmax(sA0, sA1); m_run = rm;
#pragma unroll
        for (int r = 0; r < 16; ++r) { sA0[r] = __builtin_amdgcn_exp2f(sA0[r] - rm); sA1[r] = __builtin_amdgcn_exp2f(sA1[r] - rm); }
#pragma unroll
        for (int i = 0; i < 4; ++i) { p8a[i] = pk4_fp8(sA0[4 * i], sA0[4 * i + 1], sA0[4 * i + 2], sA0[4 * i + 3]); p8b[i] = pk4_fp8(sA1[4 * i], sA1[4 * i + 1], sA1[4 * i + 2], sA1[4 * i + 3]); }
        const int cls1 = ATT_CLASS(1); ct_cur = cls1 == 0 ? cL : (cls1 == 2 ? cR : 0.f);
        { const float cm = ct_cur - m_run;
#pragma unroll
          for (int r = 0; r < 16; ++r) negm[r] = cm; }
        qkt(sB0, sB1, kp0 + 16384, qr, negm);
        if (cls1 == 1) ATT_LUTADD(sB0, sB1, 1);
        const float rm1 = rowmax(sB0, sB1); resc = false;
        if (__any(rm1 > THR)) { const float dl = __builtin_fmaxf(rm1, 0.f); m_run += dl;
#pragma unroll
            for (int r = 0; r < 16; ++r) { sB0[r] -= dl; sB1[r] -= dl; negm[r] -= dl; }
            const float f = __builtin_amdgcn_exp2f(-dl); if (hi == 0) wsf[r32] = f; resc = true; }
    }
    {
        int t = 1;
        for (; t + 2 < NT; t += 2) { ATT_WAIT_BAR(); ATT_STEP(sB0, sB1, sA0, sA1, t, true, true); ATT_STEP(sA0, sA1, sB0, sB1, t + 1, true, false); }
        ATT_WAIT_BAR(); ATT_STEP(sB0, sB1, sA0, sA1, t, false, true);
    }
    ATT_WAIT_BAR();
    {
        const LAS char* vp_ = vp0 + ((NT - 1) & 3) * 8192; const LAS char* vq_ = vq0 + ((NT - 1) & 3) * 8192;
        ATT_VRD8(0); ATT_VRD8(1);
        SBAR();
        ATT_PV8(0); ATT_VRD8(2); SBAR();
        ATT_PV8(1); ATT_VRD8(3); SBAR();
        ATT_PV8(2); ATT_VRD8(4); SBAR();
        ATT_PV8(3); SBAR();
        ATT_PV8(4); SBAR();
        asm volatile("s_nop 15\n\ts_nop 15\n\ts_nop 15\n\ts_nop 15" ::: "memory");
    }
    if (resc) { LDS_WAIT();
#pragma unroll
        for (int r = 0; r < 16; ++r) { const float fr_ = wsf[crow(r, hi)];
#pragma unroll
            for (int d = 0; d < 5; ++d) o[d][r] *= fr_; } }
#undef ATT_STEP
#undef ATT_KRD
#undef ATT_VRD8
#undef ATT_PV8
#undef ATT_CAT8
#undef SBAR
#undef ATT_LUTADD
#undef ATT_CLASS
#undef ATT_ISSUE_K
#undef ATT_ISSUE_K1
#undef ATT_ISSUE_V1
#undef ATT_ISSUE_V
    if (r32 == 0) {
#pragma unroll
        for (int r = 0; r < 16; ++r) wsf[32 + crow(r, hi)] = (1.0f / 16.0f) / o[4][r]; }
    LDS_WAIT();
#pragma unroll
    for (int r = 0; r < 16; ++r) { const float rl_ = wsf[32 + crow(r, hi)];
#pragma unroll
        for (int d = 0; d < 4; ++d) o[d][r] *= rl_; }
    ATT_BAR();
    LAS float* X = (LAS float*)shm3 + wq * 4096;
    if (mp == 1) {
#pragma unroll
        for (int d = 0; d < 4; ++d)
#pragma unroll
            for (int r = 0; r < 16; ++r) X[(d * 16 + r) * 64 + lane] = o[d][r];
    }
    ATT_BAR();
    if (mp == 0) {
#pragma unroll
        for (int d = 0; d < 4; ++d)
#pragma unroll
            for (int r = 0; r < 16; ++r) o[d][r] -= lam * X[(d * 16 + r) * 64 + lane];
        float gsc[4];
#pragma unroll
        for (int d = 0; d < 4; ++d) gsc[d] = subg[32 * d + r32] * oscale;
        LAS bf16_t* stg = (LAS bf16_t*)(shm3 + L_STG) + wq * 4096;
#pragma unroll
        for (int r = 0; r < 16; ++r) {
            float ss = (o[0][r] * o[0][r] + o[1][r] * o[1][r]) + (o[2][r] * o[2][r] + o[3][r] * o[3][r]);
#pragma unroll
            for (int x = 1; x < 32; x <<= 1) ss += __shfl_xor(ss, x);
            const float rstd = 1.0f / sqrtf(ss * (1.f / 128.f) + EPS);
#pragma unroll
            for (int d = 0; d < 4; ++d) stg[crow(r, hi) * 128 + 32 * d + r32] = (bf16_t)f2bf(o[d][r] * rstd * gsc[d]);
        }
        LDS_WAIT();
        bf16_t* Ow = mix + (rowbase + q0 + wq * 32) * D + h * 128;
#pragma unroll
        for (int i = 0; i < 8; ++i) { const int row = 4 * i + (lane >> 4), ch = lane & 15; const u32x4 v = *(const LAS u32x4*)(stg + row * 128 + ch * 8); *(u32x4*)(Ow + (long)row * D + ch * 8) = v; }
    }
    ATT_BAR();
}
}

template <int WIN>
__device__ __forceinline__ void pool_item(int g, int tok0, int lane, int r32, int hi, LAS unsigned char* st, const bf16_t* qkvp, const bf16_t* wpT, const float* pscale, bf16_t* mix) {
    constexpr int HALFW = WIN / 2, NR = 32 + WIN - 1, PITCH = 272;
    const int s0 = tok0 & (SEQ - 1);
    { const bf16_t* base = qkvp + (size_t)tok0 * INW + 1536 + g * 128 + 8 * (lane & 15);
      constexpr int NB = (NR + 3) / 4;
      u32x4 v[NB];
#pragma unroll
      for (int i = 0; i < NB; ++i) { const int ri = 4 * i + (lane >> 4), sp = min(max(s0 - HALFW + ri, 0), SEQ - 1);
          v[i] = *(const u32x4*)(base + (long)(sp - s0) * INW); }
#pragma unroll
      for (int i = 0; i < NB; ++i) { const int ri = 4 * i + (lane >> 4), sp = s0 - HALFW + ri;
          const bool ok = (sp >= 0 && sp < SEQ);
          u32x4 z; z.x = ok ? v[i].x : 0u; z.y = ok ? v[i].y : 0u; z.z = ok ? v[i].z : 0u; z.w = ok ? v[i].w : 0u;
          *(LAS u32x4*)(st + ri * PITCH + (lane & 15) * 16) = z; } }
    asm volatile("s_waitcnt lgkmcnt(0)" ::: "memory");
    const int s = s0 + r32;
    const int lo = max(s - HALFW, 0), hi_ = min(s - HALFW + WIN - 1, SEQ - 1);
    const float rc = 1.0f / (float)(hi_ - lo + 1);
    f32x16 acc[4];
#pragma unroll
    for (int cb = 0; cb < 4; ++cb)
#pragma unroll
        for (int r = 0; r < 16; ++r) acc[cb][r] = 0.f;
    const LAS unsigned char* lrow = st + r32 * PITCH + hi * 16;
#pragma unroll (WIN <= 4 ? 4 : (WIN == 8 ? 2 : 1))
    for (int ks = 0; ks < 8; ++ks) {
        bf16x8 bfr[4];
#pragma unroll
        for (int cb = 0; cb < 4; ++cb) bfr[cb] = *(const bf16x8*)(wpT + (size_t)(g * 128 + 32 * cb + r32) * 128 + 16 * ks + 8 * hi);
        float sum[8];
#pragma unroll
        for (int i = 0; i < 8; ++i) sum[i] = 0.f;
        u32x4 own;
#pragma unroll
        for (int j = 0; j < WIN; ++j) { const u32x4 v = *(const LAS u32x4*)(lrow + j * PITCH + 32 * ks); if (j == HALFW) own = v;
#pragma unroll
            for (int i = 0; i < 4; ++i) { sum[2 * i] += __builtin_bit_cast(float, v[i] << 16); sum[2 * i + 1] += __builtin_bit_cast(float, v[i] & 0xffff0000u); } }
        u32x4 aw;
#pragma unroll
        for (int i = 0; i < 4; ++i) { const float o0 = __builtin_bit_cast(float, own[i] << 16), o1 = __builtin_bit_cast(float, own[i] & 0xffff0000u);
            aw[i] = pk2(sum[2 * i] * rc - o0, sum[2 * i + 1] * rc - o1); }
        const bf16x8 af = __builtin_bit_cast(bf16x8, aw);
#pragma unroll
        for (int cb = 0; cb < 4; ++cb) acc[cb] = __builtin_amdgcn_mfma_f32_32x32x16_bf16(af, bfr[cb], acc[cb], 0, 0, 0);
    }
    asm volatile("s_waitcnt lgkmcnt(0)" ::: "memory");
#pragma unroll
    for (int cb = 0; cb < 4; ++cb) { const float ps = pscale[g * 128 + 32 * cb + r32];
#pragma unroll
        for (int r = 0; r < 16; ++r) { const int row = tok0 + (r & 3) + 8 * (r >> 2) + 4 * hi; mix[(size_t)row * D + 512 + g * 128 + 32 * cb + r32] = (bf16_t)f2bf(acc[cb][r] * ps); } }
}
__device__ __forceinline__ void pool_phase(const Frame& Fi, const bf16_t* qkvp, const bf16_t* wpT, const float* pscale, bf16_t* mix) {
    Frame F = refresh(Fi);
    const int lane = F.lane;
    const int gw = F.vcu * NWAVES + F.wave, NGW = F.G * NWAVES;
    LAS unsigned char* st = F.lds + F.wave * 16384;
    for (int it = gw; it < (NTOK / 32) * 4; it += NGW) {
        const int g = (it >= (NTOK / 32) * 2) ? 3 - (it & 3) : (it & 3), tok0 = (it >> 2) * 32;
        int r32 = lane & 31, hi = lane >> 5; asm volatile("" : "+v"(r32), "+v"(hi));
        if (g == 0) pool_item<2>(0, tok0, lane, r32, hi, st, qkvp, wpT, pscale, mix);
        else if (g == 1) pool_item<4>(1, tok0, lane, r32, hi, st, qkvp, wpT, pscale, mix);
        else if (g == 2) pool_item<8>(2, tok0, lane, r32, hi, st, qkvp, wpT, pscale, mix);
        else pool_item<16>(3, tok0, lane, r32, hi, st, qkvp, wpT, pscale, mix);
    }
}

__device__ __forceinline__ void router_phase(const Frame& Fi, const bf16_t* X, const float* g2, const float* wr, const float* br, unsigned* gcnt, int* tl, u32x2* gd, bf16_t* H2) {
    Frame F = refresh(Fi);
    const int lane = F.lane, w = F.wave, r32 = lane & 31, hi = lane >> 5;
    LAS unsigned char* xs = F.lds;
    LAS float* part = (LAS float*)(F.lds + 131584);
    LAS int* cntl = (LAS int*)(F.lds + 160256);
    LAS int* gbs = (LAS int*)(F.lds + 160384);
    LAS float* rs = (LAS float*)(F.lds + 160512);
    bf16x8 ap[8][3];
#pragma unroll
    for (int q = 0; q < 8; ++q) { unsigned pc[3][4];
#pragma unroll
        for (int i = 0; i < 8; ++i) { const int k = 128 * w + 16 * q + 8 * hi + i; const float a = wr[k * NE + r32] * g2[k];
            const unsigned b0 = __builtin_bit_cast(unsigned, a) & 0xffff0000u; const float r1 = a - __builtin_bit_cast(float, b0);
            const unsigned b1 = __builtin_bit_cast(unsigned, r1) & 0xffff0000u; const float r2 = r1 - __builtin_bit_cast(float, b1);
            const unsigned b2 = __builtin_bit_cast(unsigned, r2) & 0xffff0000u;
            if (i & 1) { pc[0][i >> 1] |= b0; pc[1][i >> 1] |= b1; pc[2][i >> 1] |= b2; } else { pc[0][i >> 1] = b0 >> 16; pc[1][i >> 1] = b1 >> 16; pc[2][i >> 1] = b2 >> 16; } }
#pragma unroll
        for (int c = 0; c < 3; ++c) ap[q][c] = __builtin_bit_cast(bf16x8, (u32x4){pc[c][0], pc[c][1], pc[c][2], pc[c][3]}); }
    u32x2 v[4][4];
    const f32x4 gq = *((const GAS f32x4*)g2 + 32 * w + r32);
    int item = F.vcu;
    if (item < NTOK / 32) {
#pragma unroll
        for (int q = 0; q < 4; ++q) load_row16(X + (size_t)(item * 32 + 4 * w + q) * D, lane, v[q]);
    }
    for (; item < NTOK / 32; item += F.G) {
        const int tok0 = item * 32;
        if (F.tid < 32) cntl[F.tid] = 0;
#pragma unroll
        for (int q = 0; q < 4; ++q) { const int r = 4 * w + q; float ss = 0.f;
#pragma unroll
            for (int j = 0; j < 4; ++j) { const f32x4 x = up4(v[q][j]); ss += (x.x * x.x + x.y * x.y) + (x.z * x.z + x.w * x.w);
                *(LAS f32x4*)(xs + r * 4096 + (((lane + 64 * j) ^ (r & 15)) << 4)) = x; }
            ss = wave_sum(ss);
            if (lane == 0) rs[r] = 1.0f / sqrtf(ss * (1.f / D) + EPS); }
        if (item + F.G < NTOK / 32) {
#pragma unroll
            for (int q = 0; q < 4; ++q) load_row16(X + (size_t)((item + F.G) * 32 + 4 * w + q) * D, lane, v[q]);
        }
        __syncthreads();
        f32x16 acc;
#pragma unroll
        for (int r = 0; r < 16; ++r) acc[r] = 0.f;
        { const LAS unsigned char* xr = xs + r32 * 4096;
#pragma unroll
          for (int q = 0; q < 8; ++q) { const int c = 32 * w + 4 * q + 2 * hi;
              const u32x4 x0 = *(const LAS u32x4*)(xr + ((c ^ (r32 & 15)) << 4)), x1 = *(const LAS u32x4*)(xr + (((c + 1) ^ (r32 & 15)) << 4));
              const bf16x8 xb = __builtin_bit_cast(bf16x8, (u32x4){__builtin_amdgcn_perm(x0.y, x0.x, 0x07060302u), __builtin_amdgcn_perm(x0.w, x0.z, 0x07060302u),
                                                                    __builtin_amdgcn_perm(x1.y, x1.x, 0x07060302u), __builtin_amdgcn_perm(x1.w, x1.z, 0x07060302u)});
#pragma unroll
              for (int pcs = 0; pcs < 3; ++pcs) acc = __builtin_amdgcn_mfma_f32_32x32x16_bf16(ap[q][pcs], xb, acc, 0, 0, 0); } }
        if (w > 0) {
#pragma unroll
            for (int r = 0; r < 16; ++r) part[((w - 1) * 16 + r) * 64 + lane] = acc[r]; }
        __syncthreads();
        if (w == 0) {
#pragma unroll
            for (int pw = 0; pw < 7; ++pw)
#pragma unroll
                for (int r = 0; r < 16; ++r) acc[r] += part[(pw * 16 + r) * 64 + lane];
            const float rstd = rs[r32];
            float lv4[16];
#pragma unroll
            for (int r = 0; r < 16; ++r) lv4[r] = acc[r] * rstd + br[(r & 3) + 8 * (r >> 2) + 4 * hi];
            float lv[4]; int le[4];
#pragma unroll
            for (int k = 0; k < 4; ++k) { float best = -INFINITY; int bi = 0;
#pragma unroll
                for (int r = 0; r < 16; ++r) { const bool gtb = lv4[r] > best; best = gtb ? lv4[r] : best; bi = gtb ? r : bi; }
                lv[k] = best; le[k] = (bi & 3) + 8 * (bi >> 2) + 4 * hi;
#pragma unroll
                for (int r = 0; r < 16; ++r) lv4[r] = (r == bi) ? -INFINITY : lv4[r]; }
            float cv[8]; int ce[8];
#pragma unroll
            for (int k = 0; k < 4; ++k) { cv[k] = lv[k]; ce[k] = le[k]; cv[4 + k] = __shfl_xor(lv[k], 32); ce[4 + k] = __shfl_xor(le[k], 32); }
            float tv[4], gt[4]; int te[4], lr[4] = {0, 0, 0, 0};
#pragma unroll
            for (int k = 0; k < 4; ++k) { float best = -INFINITY; int be = 1 << 20, bi = 0;
#pragma unroll
                for (int c = 0; c < 8; ++c) { const bool b = (cv[c] > best) || (cv[c] == best && ce[c] < be); best = b ? cv[c] : best; be = b ? ce[c] : be; bi = b ? c : bi; }
                tv[k] = best; te[k] = be;
#pragma unroll
                for (int c = 0; c < 8; ++c) cv[c] = (c == bi) ? -INFINITY : cv[c]; }
            float den = 0.f;
#pragma unroll
            for (int k = 0; k < 4; ++k) { gt[k] = __expf(tv[k] - tv[0]); den += gt[k]; }
#pragma unroll
            for (int k = 0; k < 4; ++k) gt[k] = gt[k] / den;
            if (hi == 0) {
#pragma unroll
                for (int k = 0; k < 4; ++k) lr[k] = __hip_atomic_fetch_add(cntl + te[k], 1, __ATOMIC_RELAXED, __HIP_MEMORY_SCOPE_WORKGROUP);
            }
            LDS_WAIT(); asm volatile("" ::: "memory");
            if (lane < 32) gbs[lane] = (int)__hip_atomic_fetch_add(gcnt + 64 * lane, (unsigned)cntl[lane], __ATOMIC_RELAXED, __HIP_MEMORY_SCOPE_AGENT);
            LDS_WAIT(); asm volatile("" ::: "memory");
            if (hi == 0) { const int tok = tok0 + r32;
#pragma unroll
                for (int k = 0; k < 4; ++k) { const int rk = gbs[te[k]] + lr[k]; tl[te[k] * NTOK + rk] = tok; gd[te[k] * NTOK + rk] = (u32x2){__builtin_bit_cast(unsigned, gt[k]), (unsigned)(tok * 4 + k)}; } }
        }
#pragma unroll
        for (int q = 0; q < 4; ++q)
#pragma unroll
            for (int j = 0; j < 4; ++j) asm volatile("" : "+v"(v[q][j].x), "+v"(v[q][j].y));
        { const int cc = 32 * w + r32;
#pragma unroll 4
          for (int i = 0; i < 16; ++i) { const int r = 2 * i + hi; const float rstd = rs[r];
              const f32x4 x = *(const LAS f32x4*)(xs + r * 4096 + ((cc ^ (r & 15)) << 4));
              const float rs_ = rstd * pg8::F8_SH;
              *((GAS unsigned*)((unsigned char*)H2 + (size_t)(tok0 + r) * D) + cc) = pk4_fp8(x.x * rs_ * gq.x, x.y * rs_ * gq.y, x.z * rs_ * gq.z, x.w * rs_ * gq.w); } }
        __syncthreads();
    }
}
__device__ __forceinline__ void build_tables(const Frame& Fi, unsigned* gcnt) {
    Frame F = refresh(Fi);
    LAS int* tab = (LAS int*)(F.lds + TAB_OFF);
    if (F.wave == 0) {
        const int c = (F.lane < NE) ? (int)__hip_atomic_load(gcnt + 64 * F.lane, __ATOMIC_RELAXED, __HIP_MEMORY_SCOPE_AGENT) : 0;
        const int tl = (c + 255) >> 8;
        int ps = c, pt = tl;
#pragma unroll
        for (int o = 1; o < 32; o <<= 1) { const int a = __shfl_up(ps, o), b = __shfl_up(pt, o); if (F.lane >= o) { ps += a; pt += b; } }
        if (F.lane < NE) { tab[F.lane + 1] = pt; tab[33 + F.lane + 1] = ps; tab[66 + F.lane] = c; }
        if (F.lane == 0) { tab[0] = 0; tab[33] = 0; }
    }
    __syncthreads();
}
__device__ __forceinline__ void combine_phase(const Frame& Fi, bf16_t* X, const bf16_t* y, const float* gain, bf16_t* hout, float* fout) {
    Frame F = refresh(Fi);
    const int gw = F.vcu * NWAVES + F.wave, NGW = F.G * NWAVES;
    f32x4 gn[4]; load_gain(gain, F.lane, gn);
    for (int tok0 = gw; tok0 < NTOK; tok0 += 2 * NGW) {
        f32x4 v[2][4]; u32x2 xv[2][4]; unsigned w[2][4][4];
#pragma unroll
        for (int q = 0; q < 2; ++q) { const int tok = min(tok0 + q * NGW, NTOK - 1); load_row16(X + (size_t)tok * D, F.lane, xv[q]);
#pragma unroll
            for (int k = 0; k < 4; ++k) { const GAS unsigned* yr = (const GAS unsigned*)((const unsigned char*)y + (size_t)(tok * 4 + k) * D) + F.lane;
#pragma unroll
                for (int j = 0; j < 4; ++j) w[q][k][j] = yr[64 * j]; } }
#pragma unroll
        for (int q = 0; q < 2; ++q) { const int tok = tok0 + q * NGW; if (tok >= NTOK) break;
#pragma unroll
            for (int j = 0; j < 4; ++j) v[q][j] = up4(xv[q][j]);
#pragma unroll
            for (int j = 0; j < 4; ++j) { f32x4 t = (f32x4){0.f, 0.f, 0.f, 0.f};
#pragma unroll
                for (int k = 0; k < 4; ++k) { const unsigned ww = w[q][k][j]; const f32x2 lo = __builtin_amdgcn_cvt_pk_f32_fp8((int)ww, false), hi = __builtin_amdgcn_cvt_pk_f32_fp8((int)ww, true);
                    t.x += lo[0]; t.y += lo[1]; t.z += hi[0]; t.w += hi[1]; }
                v[q][j] += t * (1.0f / pg8::F8_SY); }
            const float rstd = row_rstd(v[q]);
            if (hout) {
                GAS u32x2* xo = (GAS u32x2*)(X + (size_t)tok * D) + F.lane;
#pragma unroll
                for (int j = 0; j < 4; ++j) xo[64 * j] = (u32x2){pk2(v[q][j].x, v[q][j].y), pk2(v[q][j].z, v[q][j].w)};
                store_row_bf16(hout + (size_t)tok * D, F.lane, v[q], gn, rstd);
            } else {
                GAS f32x4* oo = (GAS f32x4*)(fout + (size_t)tok * D) + F.lane;
#pragma unroll
                for (int j = 0; j < 4; ++j) oo[64 * j] = v[q][j] * rstd * gn[j];
            }
        }
    }
}

struct Args { const float* in[22]; float* out; unsigned char* ws; };
typedef __attribute__((address_space(4))) const Args CArgs;
__device__ __forceinline__ CArgs* kargs() { CArgs* p = (CArgs*)__builtin_amdgcn_kernarg_segment_ptr(); asm volatile("" : "+s"(p)); return p; }
__global__ void __launch_bounds__(NWAVES * 64, 2) mk_fwd(Args args) {
    extern __shared__ __attribute__((aligned(16))) unsigned char lds[];
    Frame F;
    F.lds = (LAS unsigned char*)lds; F.ldsg = lds;
    F.tid = threadIdx.x; F.lane = F.tid & 63; F.wave = __builtin_amdgcn_readfirstlane(F.tid >> 6);
    F.G = gridDim.x; { const int bx = blockIdx.x; F.vcu = (F.G % 8 == 0) ? (bx % 8) * (F.G / 8) + bx / 8 : bx; }
    unsigned* ctl = (unsigned*)(kargs()->ws + WS_CTL);
    for (int u = F.tid; u < (LDS_BYTES - LDSCTL_OFF) / 4; u += NWAVES * 64) ((LAS unsigned*)(F.lds + LDSCTL_OFF))[u] = 0u;
    __syncthreads();
    (void)xcd_barrier_post(ctl + CW_BAR, (volatile LAS unsigned*)(F.lds + MISC_OFF) + 8);

#define IN(i) (kargs()->in[i])
#define WSP(off) (kargs()->ws + (off))
#define x_in IN(0)
#define rel_table IN(1)
#define norm1 IN(2)
#define w_in IN(3)
#define lq1 IN(4)
#define lk1 IN(5)
#define lq2 IN(6)
#define lk2 IN(7)
#define subln_g IN(8)
#define w_pool IN(9)
#define pool_scale IN(10)
#define w_out IN(11)
#define norm2 IN(12)
#define w_router IN(13)
#define b_router IN(14)
#define w_gate IN(15)
#define b_gate IN(16)
#define w_up IN(17)
#define b_up IN(18)
#define w_down IN(19)
#define b_down IN(20)
#define final_norm IN(21)
#define WIN ((bf16_t*)WSP(WS_WIN))
#define WOUT ((bf16_t*)WSP(WS_WOUT))
#define WPOOL ((bf16_t*)WSP(WS_WPOOL))
#define WGU ((bf16_t*)WSP(WS_WGU))
#define WDN ((bf16_t*)WSP(WS_WDN))
#define X ((bf16_t*)WSP(WS_X))
#define VT ((unsigned char*)WSP(WS_X + 64 * MiB))
#define QKVP ((bf16_t*)WSP(RA_QKVP))
#define MIX ((bf16_t*)WSP(RA_MIX))
#define H ((bf16_t*)WSP(RA_H))
#define ACT ((bf16_t*)WSP(WS_RA))
#define H2 ((bf16_t*)WSP(WS_RB))
#define Y ((bf16_t*)WSP(WS_RB))
#define rt_e ((int*)WSP(RT_E))
#define rt_rank ((int*)WSP(RT_RANK))
#define rt_tl ((int*)WSP(RT_TL))
#define rt_gl ((u32x2*)WSP(RT_GL))
    const int gw = F.vcu * NWAVES + F.wave, NGW = F.G * NWAVES;

    {
        LAS float* scr = (LAS float*)(F.lds + F.wave * 16384);
        constexpr int I_IN = (D / 64) * (INW / 32), I_OUT = (D / 64) * (D / 32), I_POOL = 4 * 2 * 4;
        constexpr int PER_L = I_IN + I_OUT + I_POOL;
        for (int it = gw; it < DEPTH * PER_L; it += NGW) {
            const int l = it / PER_L; int r = it % PER_L;
            if (r < I_IN) { const int kb = r / (INW / 32), nb = r % (INW / 32); transpose_item(w_in + (size_t)l * D * INW, D, INW, WIN + (size_t)l * INW * D, 0, scr, 64 * kb, 32 * nb, F.lane); continue; } r -= I_IN;
            if (r < I_OUT) { const int kb = r / (D / 32), nb = r % (D / 32); transpose_item(w_out + (size_t)l * D * D, D, D, WOUT + (size_t)l * D * D, 0, scr, 64 * kb, 32 * nb, F.lane); continue; } r -= I_OUT;
            { const int g = r >> 3, q = r & 7, kb = q >> 2, nb = q & 3; transpose_item(w_pool + (size_t)(l * 4 + g) * 128 * 128, 128, 128, WPOOL + (size_t)(l * 4 + g) * 128 * 128, 0, scr, 64 * kb, 32 * nb, F.lane); }
        }
        convert_experts(F, w_gate, w_up, w_down, WGU, WDN);
        f32x4 gn[4]; load_gain(norm1, F.lane, gn);
        for (int tok = gw; tok < NTOK; tok += NGW) { f32x4 v[4]; load_row(x_in + (size_t)tok * D, F.lane, v); const float rstd = row_rstd(v); store_row_bf16(H + (size_t)tok * D, F.lane, v, gn, rstd); }
    }
    GRID_SYNC();

    for (int l = 0; l < DEPTH; ++l) {
        {
            pg8::Gemm g{H, WIN + (size_t)l * INW * D, D, nullptr}; pg8::DenseOrder S; S.init(NTOK, INW, (int)gridDim.x, (int)blockIdx.x);
            pg8::EpiQkvp E{QKVP};
            pg8::gemm_phase<pg8::EpiQkvp, pg8::DenseOrder>(F.lds, g, S, E);
        }
        GRID_SYNC();
        vt_phase(F, QKVP, VT);
        GRID_SYNC();
        {
            const float lam_init = 0.8f - 0.6f * expf(-0.3f * (float)l);
            const float d1 = wave_sum(lq1[l * 64 + F.lane] * lk1[l * 64 + F.lane]), d2 = wave_sum(lq2[l * 64 + F.lane] * lk2[l * 64 + F.lane]);
            const float lam = expf(d1) - expf(d2) + lam_init;
            const Frame Fa = refresh(F);
            const int xcd = Fa.vcu / (Fa.G / 8), j = Fa.vcu % (Fa.G / 8), per = Fa.G / 8;
            for (int bh2 = 0; bh2 < 2; ++bh2)
                for (int qb = j; qb < SEQ / 128; qb += per) {
                    const int bh = 2 * xcd + bh2;
                    att::attn_unit(bh >> 2, bh & 3, qb, QKVP, VT, MIX, F.ldsg, rel_table, lam, subln_g + l * 128, 1.0f - lam_init);
                }
            pool_phase(F, QKVP, WPOOL + (size_t)l * 4 * 128 * 128, pool_scale + l * 512, MIX);
        }
        GRID_SYNC();
        {
            pg8::Gemm g{MIX, WOUT + (size_t)l * D * D, D, nullptr}; pg8::DenseOrder S; S.init(NTOK, D, (int)gridDim.x, (int)blockIdx.x);
            pg8::EpiResid E{l == 0 ? x_in : nullptr, X, X};
            pg8::gemm_phase<pg8::EpiResid, pg8::DenseOrder>(F.lds, g, S, E);
        }
        GRID_SYNC();
        unsigned* gcnt = (unsigned*)(kargs()->ws + WS_CTL) + CW_ECNT + 64 * NE * l;
        router_phase(F, X, norm2 + l * D, w_router + (size_t)l * D * NE, b_router + l * NE, gcnt, rt_tl, rt_gl, H2);
        GRID_SYNC();
        build_tables(F, gcnt);
        const LAS int* tab = (const LAS int*)(F.lds + TAB_OFF);
        const int ntile = rfl(tab[32]);
        {
            pg8::Gemm g{H2, WGU, D / 2, rt_tl}; pg8::MoeOrder S{tab, 8, 2 * D, 128, ntile * 8, (int)gridDim.x, (int)blockIdx.x, 0};
            pg8::EpiSwiglu E{ACT, b_gate + (size_t)l * NE * D, b_up + (size_t)l * NE * D};
            pg8::gemm_phase<pg8::EpiSwiglu, pg8::MoeOrder, true, true>(F.lds, g, S, E);
        }
        GRID_SYNC();
        {
            pg8::Gemm g{ACT, WDN, D / 2, nullptr}; pg8::MoeOrder S{tab, 4, D, 256, ntile * 4, (int)gridDim.x, (int)blockIdx.x, 1};
            pg8::EpiDown E{Y, b_down + (size_t)l * NE * D, rt_gl};
            pg8::gemm_phase<pg8::EpiDown, pg8::MoeOrder, false, true>(F.lds, g, S, E);
        }
        GRID_SYNC();
        if (l + 1 < DEPTH) {
            convert_experts(F, w_gate + (size_t)(l + 1) * NE * D * D, w_up + (size_t)(l + 1) * NE * D * D, w_down + (size_t)(l + 1) * NE * D * D, WGU, WDN);
            combine_phase(F, X, Y, norm1 + (l + 1) * D, H, nullptr);
            GRID_SYNC();
        } else {
            combine_phase(F, X, Y, final_norm, nullptr, kargs()->out);
        }
    }
}

extern "C" void kernel_launch(void* const* d_in, const int* in_sizes, int n_in, void* d_out, int out_size, void* d_ws, size_t ws_size, hipStream_t stream) {
    static int grid = 0;
    if (grid == 0) {
        if (n_in != 22 || in_sizes[0] != NTOK * D || out_size != NTOK * D || ws_size < WS_END) { fprintf(stderr, "kernel_launch: unexpected shapes (n_in %d, in0 %d, out %d, ws %zu)\n", n_in, n_in > 0 ? in_sizes[0] : -1, out_size, ws_size); grid = -1; return; }
        int dev = 0, cus = 0, per_cu = 0;
        if (hipGetDevice(&dev) != hipSuccess || hipDeviceGetAttribute(&cus, hipDeviceAttributeMultiprocessorCount, dev) != hipSuccess) { grid = -1; return; }
        if (hipFuncSetAttribute((const void*)mk_fwd, hipFuncAttributeMaxDynamicSharedMemorySize, LDS_BYTES) != hipSuccess) { fprintf(stderr, "kernel_launch: hipFuncSetAttribute failed\n"); grid = -1; return; }
        if (hipOccupancyMaxActiveBlocksPerMultiprocessor(&per_cu, (const void*)mk_fwd, NWAVES * 64, LDS_BYTES) != hipSuccess || per_cu < 1) fprintf(stderr, "kernel_launch: occupancy query reports %d\n", per_cu);
        (void)hipGetLastError();
        grid = cus;
        if (grid != 256) { fprintf(stderr, "kernel_launch: built for a 256-CU device (the expert-GEMM gather table holds 17 units per workgroup); found %d CUs, nothing launched\n", cus); grid = -1; return; }
    }
    if (grid < 0) return;
    if (hipMemsetAsync((char*)d_ws + WS_CTL, 0, CTL_ZERO_BYTES, stream) != hipSuccess) return;
    Args a{};
    for (int i = 0; i < 22; ++i) a.in[i] = (const float*)d_in[i];
    a.out = (float*)d_out; a.ws = (unsigned char*)d_ws;
    hipLaunchKernelGGL(mk_fwd, dim3(grid), dim3(NWAVES * 64), LDS_BYTES, stream, a);
}
```

```cpp
#include <hip/hip_runtime.h>
#include <cstdio>
#include <cstdint>

#define LAS __attribute__((address_space(3)))
#define GAS __attribute__((address_space(1)))
typedef unsigned short bf16_t;
typedef short bf16x8 __attribute__((ext_vector_type(8)));
typedef short s16x4 __attribute__((ext_vector_type(4)));
typedef float f32x2 __attribute__((ext_vector_type(2)));
typedef float f32x4 __attribute__((ext_vector_type(4)));
typedef int i32x8 __attribute__((ext_vector_type(8)));
typedef float f32x16 __attribute__((ext_vector_type(16)));
typedef unsigned u32x2 __attribute__((ext_vector_type(2)));
typedef unsigned u32x4 __attribute__((ext_vector_type(4)));
typedef GAS unsigned gu32;

constexpr int D = 1024, BATCH = 4, SEQ = 8192, NTOK = BATCH * SEQ, DEPTH = 2;
constexpr int NH = 4, INW = 2048, NE = 32, TOPK = 4, NASG = NTOK * TOPK;
constexpr float EPS = 1e-5f, LOG2E = 1.4426950408889634f;
constexpr float QSCALE = 0.125f * LOG2E;
constexpr int NWAVES = 8;

constexpr size_t MiB = 1u << 20;
constexpr size_t WS_CTL = 0, CTL_ZERO_BYTES = 1 * MiB;
constexpr size_t WS_WIN = 1 * MiB;
constexpr size_t WS_WOUT = 9 * MiB;
constexpr size_t WS_WPOOL = 13 * MiB;
constexpr size_t WS_ROUTE = 14 * MiB;
constexpr size_t WS_WGU = 18 * MiB;
constexpr size_t WS_WDN = 146 * MiB;
constexpr size_t WS_X = 210 * MiB;
constexpr size_t WS_RA = 338 * MiB;
constexpr size_t WS_RB = 595 * MiB;
constexpr size_t RT_TL = 852 * MiB, RT_GL = 856 * MiB;
constexpr size_t WS_END = 864 * MiB;
constexpr size_t RA_QKVP = WS_RA, RA_MIX = WS_RA + 128 * MiB, RA_H = WS_RA + 192 * MiB;
constexpr size_t RT_E = WS_ROUTE, RT_RANK = WS_ROUTE + 512 * 1024, RT_GATE = WS_ROUTE + 1024 * 1024, RT_POS = WS_ROUTE + 1536 * 1024, RT_GS = WS_ROUTE + 2048 * 1024;
constexpr int CW_BAR = 4096, CW_ECNT = 16384;

constexpr int RING_BYTES = 131072;
constexpr int LDSCTL_OFF = RING_BYTES;
constexpr int MISC_OFF = LDSCTL_OFF + 320;
constexpr int TAB_OFF = LDSCTL_OFF + 1024;
constexpr int GTAB_OFF_ = 133120;
constexpr int LDS_BYTES = 163840;

#define LDS_WAIT() asm volatile("s_waitcnt lgkmcnt(0)" ::: "memory")
#define VM_WAIT() asm volatile("s_waitcnt vmcnt(0)" ::: "memory")
__device__ __forceinline__ unsigned f2bf(float f) { unsigned u = __builtin_bit_cast(unsigned, f); return (u + 0x7fffu + ((u >> 16) & 1u)) >> 16; }
__device__ __forceinline__ unsigned pk2(float lo, float hi) { return f2bf(lo) | (f2bf(hi) << 16); }
__device__ __forceinline__ float bf2f(unsigned short b) { return __builtin_bit_cast(float, (unsigned)b << 16); }
__device__ __forceinline__ unsigned cvt_pk_bf16(float lo, float hi) { unsigned r; asm volatile("v_cvt_pk_bf16_f32 %0, %1, %2" : "=v"(r) : "v"(lo), "v"(hi)); return r; }
__device__ __forceinline__ int rfl(int v) { return __builtin_amdgcn_readfirstlane(v); }
__device__ __forceinline__ unsigned pk4_fp8(float a, float b, float c, float d) { int w; asm("" : "=v"(w)); w = __builtin_amdgcn_cvt_pk_fp8_f32(a, b, w, false); return (unsigned)__builtin_amdgcn_cvt_pk_fp8_f32(c, d, w, true); }

namespace pg8 {
constexpr int BM = 256, BK = 64, HALF = 128, HTB = HALF * BK * 2, STAGE_BYTES = 8 * HTB, NXCD = 8, WGM = 8;
constexpr int GTAB_OFF = 133120, GTAB_UNITS = 17;
constexpr float F8_SH = 8.0f, F8_SG = 64.0f;
constexpr float F8_SY = 4.0f;
constexpr float F8_SA = 4.0f, F8_SW = 64.0f;
__host__ __device__ __forceinline__ int lds_byte(int r, int c) { const int st = (r >> 4) * 2 + (c >> 5), rr = r & 15, cc = c & 31, ob = rr * 64 + cc * 2; return st * 1024 + (ob ^ (((ob >> 9) & 1) << 5)); }
__host__ __device__ __forceinline__ void stage_rc(int b, int& R, int& C) { const int st = b / 1024, sb = b % 1024, swz = sb ^ (((sb >> 9) & 1) << 5); R = (st >> 1) * 16 + swz / 64; C = (st & 1) * 32 + (swz % 64) / 2; }
__host__ __device__ __forceinline__ int perm32(int rho) { const int n = rho >> 4, i = rho & 15; return 8 * (i >> 2) + 4 * n + (i & 3); }

struct Unit { int arow, brow, orow, ocol, valid, e, grow; };
struct Gemm { const bf16_t* A; const bf16_t* Bt; int K; const int* tl; };

struct DenseOrder {
    int nM, nN, nwg, G, c;
    __device__ void init(int M, int N, int G_, int c_) { nM = M / BM; nN = N / BM; nwg = nM * nN; G = G_; c = c_; }
    __device__ bool next(int i, Unit& u) const {
        const long L = (long)i * G + c; if (L >= nwg) return false;
        int wgid = (int)L; { const int q = nwg / NXCD, r = nwg % NXCD, xcd = wgid % NXCD, off = wgid / NXCD; wgid = (xcd < r ? xcd * (q + 1) : r * (q + 1) + (xcd - r) * q) + off; }
        const int nig = WGM * nN, gid = wgid / nig, fm = gid * WGM, gsz = (nM - fm) < WGM ? (nM - fm) : WGM;
        const int pm = fm + ((wgid % nig) % gsz), pn = (wgid % nig) / gsz;
        u.arow = pm * BM; u.brow = pn * BM; u.orow = pm * BM; u.ocol = pn * BM; u.valid = BM; u.e = 0; u.grow = 0; return true;
    }
};
struct MoeOrder {
    const LAS int* tab; int nct, nb, ocw, total, G, c, rev;
    __device__ bool next(int i, Unit& u) const {
        const long L = (long)i * G + c; if (L >= total) return false;
        int wgid = (int)L; { const int q = total / NXCD, r = total % NXCD, xcd = wgid % NXCD, off = wgid / NXCD, len = q + (xcd < r ? 1 : 0); wgid = (xcd < r ? xcd * (q + 1) : r * (q + 1) + (xcd - r) * q) + (rev ? len - 1 - off : off); }
        const int T = wgid / nct, pn = wgid % nct;
        const int ln = (int)__builtin_amdgcn_mbcnt_hi(~0u, __builtin_amdgcn_mbcnt_lo(~0u, 0u)) & 31;
        const int tpv = tab[ln], rbv = tab[33 + ln], cnv = tab[66 + ln];
        const int e = __builtin_popcountll(__builtin_amdgcn_ballot_w64(T >= tpv)) / 2 - 1;
        const int rt = T - __builtin_amdgcn_readlane(tpv, e); const int rb = __builtin_amdgcn_readlane(rbv, e), cn = __builtin_amdgcn_readlane(cnv, e);
        const int left = cn - BM * rt;
        u.e = e; u.arow = rb + BM * rt; u.orow = u.arow; u.valid = left < BM ? left : BM; u.brow = e * nb + pn * BM; u.ocol = pn * ocw; u.grow = e * NTOK + BM * rt; return true;
    }
};

struct EpiQkvp {
    static constexpr bool PERM = true;
    bf16_t* O;
    __device__ __forceinline__ void init(f32x4 (&acc)[2][2][4][2], const Unit&, int, int) const {
#pragma unroll
        for (int a = 0; a < 2; ++a)
#pragma unroll
            for (int b = 0; b < 2; ++b)
#pragma unroll
                for (int m = 0; m < 4; ++m)
#pragma unroll
                    for (int n = 0; n < 2; ++n) acc[a][b][m][n] = (f32x4){0.f, 0.f, 0.f, 0.f};
    }
    __device__ __forceinline__ void operator()(const f32x4 (&acc)[2][2][4][2], const Unit& u, int wr, int wc, int fr, int fq) const {
        const int row0 = u.orow + wr * 64 + fr, col0 = u.ocol + wc * 32 + 8 * fq; const float sc = (u.ocol < 512) ? QSCALE : 1.f;
#pragma unroll
        for (int ai = 0; ai < 2; ++ai)
#pragma unroll
            for (int m = 0; m < 4; ++m) { bf16_t* rowp = O + (size_t)(row0 + ai * HALF + m * 16) * INW + col0;
#pragma unroll
                for (int bj = 0; bj < 2; ++bj) { const f32x4 v0 = acc[ai][bj][m][0] * sc, v1 = acc[ai][bj][m][1] * sc;
                    u32x4 w; w.x = cvt_pk_bf16(v0[0], v0[1]); w.y = cvt_pk_bf16(v0[2], v0[3]); w.z = cvt_pk_bf16(v1[0], v1[1]); w.w = cvt_pk_bf16(v1[2], v1[3]);
                    *(u32x4*)(rowp + bj * HALF) = w; } }
    }
};
struct EpiResid {
    static constexpr bool PERM = true;
    const float* xin32; const bf16_t* xin16; bf16_t* xout;
    __device__ __forceinline__ void init(f32x4 (&acc)[2][2][4][2], const Unit&, int, int) const {
#pragma unroll
        for (int a = 0; a < 2; ++a)
#pragma unroll
            for (int b = 0; b < 2; ++b)
#pragma unroll
                for (int m = 0; m < 4; ++m)
#pragma unroll
                    for (int n = 0; n < 2; ++n) acc[a][b][m][n] = (f32x4){0.f, 0.f, 0.f, 0.f};
    }
    __device__ __forceinline__ void operator()(const f32x4 (&acc)[2][2][4][2], const Unit& u, int wr, int wc, int fr, int fq) const {
        const int row0 = u.orow + wr * 64 + fr, col0 = u.ocol + wc * 32 + 8 * fq;
#define RES_OFF(bt, ml) ((size_t)(row0 + ((bt) >> 1) * HALF + (2 * ((bt) & 1) + (ml)) * 16) * D + col0)
        if (xin32) {
            f32x4 t[2][2][2][2];
#define RES_LD32(bt) do { _Pragma("unroll") for (int ml = 0; ml < 2; ++ml) _Pragma("unroll") for (int bj = 0; bj < 2; ++bj) { const float* p_ = xin32 + RES_OFF(bt, ml) + bj * HALF; \
                t[(bt) & 1][ml][bj][0] = *(const f32x4*)p_; t[(bt) & 1][ml][bj][1] = *(const f32x4*)(p_ + 4); } asm volatile("" ::: "memory"); } while (0)
            RES_LD32(0);
#pragma unroll
            for (int bt = 0; bt < 4; ++bt) {
                if (bt == 0) RES_LD32(1); else if (bt == 1) RES_LD32(2); else if (bt == 2) RES_LD32(3);
                const int ai = bt >> 1;
#pragma unroll
                for (int ml = 0; ml < 2; ++ml) { const int m = 2 * (bt & 1) + ml;
#pragma unroll
                    for (int bj = 0; bj < 2; ++bj) { const f32x4 v0 = t[bt & 1][ml][bj][0] + acc[ai][bj][m][0], v1 = t[bt & 1][ml][bj][1] + acc[ai][bj][m][1];
                        u32x4 w; w.x = cvt_pk_bf16(v0[0], v0[1]); w.y = cvt_pk_bf16(v0[2], v0[3]); w.z = cvt_pk_bf16(v1[0], v1[1]); w.w = cvt_pk_bf16(v1[2], v1[3]);
                        *(u32x4*)(xout + RES_OFF(bt, ml) + bj * HALF) = w; } }
                asm volatile("" ::: "memory");
            }
#undef RES_LD32
        } else {
            u32x4 t[2][2][2];
#define RES_LD16(bt) do { _Pragma("unroll") for (int ml = 0; ml < 2; ++ml) _Pragma("unroll") for (int bj = 0; bj < 2; ++bj) t[(bt) & 1][ml][bj] = *(const u32x4*)(xin16 + RES_OFF(bt, ml) + bj * HALF); \
                asm volatile("" ::: "memory"); } while (0)
            RES_LD16(0);
#pragma unroll
            for (int bt = 0; bt < 4; ++bt) {
                if (bt == 0) RES_LD16(1); else if (bt == 1) RES_LD16(2); else if (bt == 2) RES_LD16(3);
                const int ai = bt >> 1;
#pragma unroll
                for (int ml = 0; ml < 2; ++ml) { const int m = 2 * (bt & 1) + ml;
#pragma unroll
                    for (int bj = 0; bj < 2; ++bj) { const u32x4 b = t[bt & 1][ml][bj]; const f32x4 a0 = acc[ai][bj][m][0], a1 = acc[ai][bj][m][1];
                        u32x4 w; w.x = cvt_pk_bf16(a0[0] + __builtin_bit_cast(float, b.x << 16), a0[1] + __builtin_bit_cast(float, b.x & 0xffff0000u));
                        w.y = cvt_pk_bf16(a0[2] + __builtin_bit_cast(float, b.y << 16), a0[3] + __builtin_bit_cast(float, b.y & 0xffff0000u));
                        w.z = cvt_pk_bf16(a1[0] + __builtin_bit_cast(float, b.z << 16), a1[1] + __builtin_bit_cast(float, b.z & 0xffff0000u));
                        w.w = cvt_pk_bf16(a1[2] + __builtin_bit_cast(float, b.w << 16), a1[3] + __builtin_bit_cast(float, b.w & 0xffff0000u));
                        *(u32x4*)(xout + RES_OFF(bt, ml) + bj * HALF) = w; } }
                asm volatile("" ::: "memory");
            }
#undef RES_LD16
        }
#undef RES_OFF
    }
};
struct EpiSwiglu {
    static constexpr bool PERM = true;
    bf16_t* act; const float* bg; const float* bu;
    __device__ __forceinline__ void init(f32x4 (&acc)[2][2][4][2], const Unit& u, int wc, int fq) const {
        const int col0 = u.ocol + wc * 32 + 8 * fq;
#pragma unroll
        for (int n = 0; n < 2; ++n) { const f32x4 vg = *(const f32x4*)(bg + u.e * D + col0 + 4 * n) * (F8_SH * F8_SG), vu = (*(const f32x4*)(bu + u.e * D + col0 + 4 * n) + 1.0f) * (F8_SH * F8_SG);
#pragma unroll
            for (int ai = 0; ai < 2; ++ai)
#pragma unroll
                for (int m = 0; m < 4; ++m) { acc[ai][0][m][n] = vg; acc[ai][1][m][n] = vu; } }
    }
    __device__ __forceinline__ void operator()(const f32x4 (&acc)[2][2][4][2], const Unit& u, int wr, int wc, int fr, int fq) const {
        const int col0 = u.ocol + wc * 32 + 8 * fq;
#pragma unroll
        for (int ai = 0; ai < 2; ++ai)
#pragma unroll
            for (int m = 0; m < 4; ++m) { const int rl = ai * HALF + wr * 64 + m * 16 + fr;
                float o[8];
#pragma unroll
                for (int n = 0; n < 2; ++n) { f32x4 g, u1;
#pragma unroll
                    for (int i = 0; i < 4; ++i) { float g_, u_;
                        asm("v_min_f32 %0, %1, %2" : "=v"(g_) : "s"(7.0f * (F8_SH * F8_SG)), "v"(acc[ai][0][m][n][i]));
                        asm("v_med3_f32 %0, %1, %2, %3" : "=v"(u_) : "v"(acc[ai][1][m][n][i]), "s"(-6.0f * (F8_SH * F8_SG)), "v"(8.0f * (F8_SH * F8_SG))); g[i] = g_; u1[i] = u_; }
                    f32x4 e = g * (-1.702f * LOG2E / (F8_SH * F8_SG));
#pragma unroll
                    for (int i = 0; i < 4; ++i) e[i] = __builtin_amdgcn_exp2f(e[i]);
                    e = e + 1.0f;
#pragma unroll
                    for (int i = 0; i < 4; ++i) e[i] = __builtin_amdgcn_rcpf(e[i]);
                    const f32x4 r = u1 * (g * e) * (F8_SA / ((F8_SH * F8_SG) * (F8_SH * F8_SG)));
#pragma unroll
                    for (int i = 0; i < 4; ++i) o[4 * n + i] = r[i]; }
                if (rl < u.valid) { u32x2 w; w.x = pk4_fp8(o[0], o[1], o[2], o[3]); w.y = pk4_fp8(o[4], o[5], o[6], o[7]);
                    *(u32x2*)((unsigned char*)act + (size_t)(u.orow + rl) * D + col0) = w; } }
    }
};
struct EpiDown {
    static constexpr bool PERM = true;
    bf16_t* y; const float* bd; const u32x2* gs;
    __device__ __forceinline__ void init(f32x4 (&acc)[2][2][4][2], const Unit& u, int wc, int fq) const {
        const int col0 = u.ocol + wc * 32 + 8 * fq;
#pragma unroll
        for (int bj = 0; bj < 2; ++bj)
#pragma unroll
            for (int n = 0; n < 2; ++n) { const f32x4 bv = *(const f32x4*)(bd + u.e * D + col0 + bj * HALF + 4 * n) * (F8_SA * F8_SW);
#pragma unroll
                for (int ai = 0; ai < 2; ++ai)
#pragma unroll
                    for (int m = 0; m < 4; ++m) acc[ai][bj][m][n] = bv; }
    }
    __device__ __forceinline__ void operator()(const f32x4 (&acc)[2][2][4][2], const Unit& u, int wr, int wc, int fr_, int fq_) const {
        int fr = fr_, fq = fq_; asm volatile("" : "+v"(fr), "+v"(fq));
        const int col0 = u.ocol + wc * 32 + 8 * fq;
        u32x2 gtv[2][4];
#pragma unroll
        for (int ai = 0; ai < 2; ++ai)
#pragma unroll
            for (int m = 0; m < 4; ++m) { const int rl = ai * HALF + wr * 64 + m * 16 + fr; gtv[ai][m] = gs[u.grow + (rl < u.valid ? rl : 0)]; }
#pragma unroll
        for (int ai = 0; ai < 2; ++ai)
#pragma unroll
            for (int m = 0; m < 4; ++m) asm volatile("" : "+v"(gtv[ai][m].x), "+v"(gtv[ai][m].y) :: "memory");
#pragma unroll
        for (int ai = 0; ai < 2; ++ai)
#pragma unroll
            for (int m = 0; m < 4; ++m) { const int rl = ai * HALF + wr * 64 + m * 16 + fr;
                const float gt = __builtin_bit_cast(float, gtv[ai][m].x) * (F8_SY / (F8_SA * F8_SW)); unsigned char* rowp = (unsigned char*)y + (size_t)gtv[ai][m].y * D + col0;
                u32x2 w[2];
#pragma unroll
                for (int bj = 0; bj < 2; ++bj) { const f32x4 v0 = acc[ai][bj][m][0] * gt, v1 = acc[ai][bj][m][1] * gt;
                    w[bj].x = pk4_fp8(v0[0], v0[1], v0[2], v0[3]); w[bj].y = pk4_fp8(v1[0], v1[1], v1[2], v1[3]); }
                if (rl < u.valid) { *(u32x2*)(rowp) = w[0]; *(u32x2*)(rowp + HALF) = w[1]; } }
    }
};

template <class Epi, class Sched, bool GATHER = false, bool FP8 = false>
__device__ __forceinline__ void gemm_phase(LAS unsigned char* lds, const Gemm g, const Sched& S, const Epi& E) {
    int tid_ = threadIdx.x; asm volatile("" : "+v"(tid_));
    const int tid = tid_, wid = __builtin_amdgcn_readfirstlane(tid >> 6), lane = tid & 63, wr = wid >> 2, wc = wid & 3, fr = lane & 15, fq = lane >> 4;
    const int K = g.K, nt = K / BK;
    unsigned voffA[2], voffB[2], cA2[2]; int rA[2];
    unsigned gqc[2][2];
#pragma unroll
    for (int i = 0; i < 2; ++i) { int R, C; stage_rc(tid * 16 + i * 8192, R, C); const int Rb = Epi::PERM ? ((R & ~31) + perm32(R & 31)) : R;
        voffA[i] = (unsigned)(R * K + C) * 2u; voffB[i] = (unsigned)(Rb * K + C) * 2u; rA[i] = R; cA2[i] = (unsigned)C * 2u; }
    const size_t kstep = (size_t)(BK * 2);
    const size_t hstep = (size_t)HALF * K * 2;
    const size_t rstep = (size_t)K * 2;
    const unsigned ldsw = (unsigned)wid * 1024u;
    const int aoff = lds_byte(wr * 64 + fr, fq * 8), boff = lds_byte(wc * 32 + fr, fq * 8);
#define PG8_SA(b, h) (((b) * 2 + (h)) * HTB)
#define PG8_SB(b, h) ((4 + (b) * 2 + (h)) * HTB)
#define PG8_STAGE(bufoff, gbase, voff) do { _Pragma("unroll") for (int _i = 0; _i < 2; ++_i) \
        __builtin_amdgcn_global_load_lds((const unsigned*)((const char*)(gbase) + (voff)[_i]), (LAS unsigned*)(lds + (bufoff) + ldsw + _i * 8192), 16, 0, 0); } while (0)
#define PG8_STAGE_A(bufoff, ptr, h, kt, gq) do { if constexpr (GATHER) { const char* gb_ = (const char*)g.A + (size_t)(kt) * kstep; PG8_STAGE(bufoff, gb_, (gq)[h]); } else { PG8_STAGE(bufoff, (ptr) + (h) * hstep, voffA); } } while (0)
#define PG8_GLOAD(gq, uidx) do { _Pragma("unroll") for (int h_ = 0; h_ < 2; ++h_) _Pragma("unroll") for (int i_ = 0; i_ < 2; ++i_) { \
        const int tok_ = gtab[(uidx) * BM + h_ * HALF + rA[i_]]; (gq)[h_][i_] = (unsigned)tok_ * (unsigned)rstep + cA2[i_]; } } while (0)
#define PG8_LDA(dst, b, h) do { _Pragma("unroll") for (int m = 0; m < 4; ++m) _Pragma("unroll") for (int k = 0; k < 2; ++k) dst[m][k] = *(const LAS bf16x8*)(lds + PG8_SA(b, h) + aoff + m * 2048 + k * 1024); } while (0)
#define PG8_LDB(dst, b, h) do { _Pragma("unroll") for (int n = 0; n < 2; ++n) _Pragma("unroll") for (int k = 0; k < 2; ++k) dst[n][k] = *(const LAS bf16x8*)(lds + PG8_SB(b, h) + boff + n * 2048 + k * 1024); } while (0)
#define PG8_CAT(x0, x1) __builtin_bit_cast(i32x8, __builtin_shufflevector(x0, x1, 0, 1, 2, 3, 4, 5, 6, 7, 8, 9, 10, 11, 12, 13, 14, 15))
#define PG8_MMA(ai, bj, At, Bt) do { __builtin_amdgcn_s_setprio(1); if constexpr (FP8) { _Pragma("unroll") for (int m = 0; m < 4; ++m) _Pragma("unroll") for (int n = 0; n < 2; ++n) \
        { const i32x8 a8_ = PG8_CAT(Bt[n][0], Bt[n][1]), b8_ = PG8_CAT(At[m][0], At[m][1]); \
          asm volatile("v_mfma_scale_f32_16x16x128_f8f6f4 %0, %1, %2, %0, %3, %3 op_sel_hi:[0,0,0]" : "+v"(acc[ai][bj][m][n]) : "v"(a8_), "v"(b8_), "v"(f8one)); } } else { \
        _Pragma("unroll") for (int m = 0; m < 4; ++m) _Pragma("unroll") for (int n = 0; n < 2; ++n) _Pragma("unroll") for (int k = 0; k < 2; ++k) \
        acc[ai][bj][m][n] = __builtin_amdgcn_mfma_f32_16x16x32_bf16(Bt[n][k], At[m][k], acc[ai][bj][m][n], 0, 0, 0); } __builtin_amdgcn_s_setprio(0); } while (0)
#define PG8_WAIT_V(n) asm volatile("s_waitcnt vmcnt(" #n ")" ::: "memory")
#define PG8_WAIT_L(n) asm volatile("s_waitcnt lgkmcnt(" #n ")" ::: "memory")
#define PG8_BAR __builtin_amdgcn_s_barrier()
#define PG8_SCHED __builtin_amdgcn_sched_barrier(0)
    Unit cur, nxt; int ui = 0;
    if (!S.next(0, cur)) return;
    f32x4 acc[2][2][4][2];
    int f8one = 0x7f7f7f7f; asm volatile("" : "+v"(f8one));
    E.init(acc, cur, wc, fq);
    bf16x8 At[4][2], B0[2][2], B1[2][2];
    const char* cA = (const char*)g.A + (size_t)cur.arow * rstep; const char* cB = (const char*)g.Bt + (size_t)cur.brow * rstep;
    LAS int* gtab = (LAS int*)(lds + GTAB_OFF);
    if constexpr (GATHER) {
        Unit uu;
        for (int i = wid; i < GTAB_UNITS && S.next(i, uu); i += 8) {
            int tk[4];
#pragma unroll
            for (int q = 0; q < 4; ++q) { const int r = lane + 64 * q; tk[q] = g.tl[uu.grow + (r < uu.valid ? r : 0)]; }
#pragma unroll
            for (int q = 0; q < 4; ++q) gtab[i * BM + lane + 64 * q] = tk[q]; }
        asm volatile("s_waitcnt vmcnt(0) lgkmcnt(0)" ::: "memory"); __builtin_amdgcn_s_barrier(); asm volatile("" ::: "memory");
        PG8_GLOAD(gqc, 0);
    }
    PG8_STAGE(PG8_SB(0, 0), cB, voffB); PG8_STAGE(PG8_SB(0, 1), cB + hstep, voffB); PG8_STAGE_A(PG8_SA(0, 0), cA, 0, 0, gqc); PG8_STAGE_A(PG8_SA(0, 1), cA, 1, 0, gqc);
    if (wr == 1) PG8_BAR;
    PG8_WAIT_V(2); PG8_BAR;
    PG8_STAGE(PG8_SB(1, 0), cB + kstep, voffB); PG8_STAGE_A(PG8_SA(1, 0), cA + kstep, 0, 1, gqc); PG8_STAGE(PG8_SB(1, 1), cB + hstep + kstep, voffB);
    PG8_WAIT_V(6); PG8_BAR;
    for (;;) {
        const bool has_next = S.next(ui + 1, nxt);
        const char* nA = has_next ? (const char*)g.A + (size_t)nxt.arow * rstep : cA; const char* nB = has_next ? (const char*)g.Bt + (size_t)nxt.brow * rstep : cB;
        const int un = has_next ? ui + 1 : ui;
#pragma unroll 1
        for (int t = 0; t < nt; t += 2) {
            const bool last = (t == nt - 2);
            const char* a1 = cA + (size_t)(t + 1) * kstep;
            const char* a2 = last ? nA : cA + (size_t)(t + 2) * kstep; const char* b2 = last ? nB : cB + (size_t)(t + 2) * kstep;
            const char* a3 = a2 + kstep; const char* b3 = b2 + kstep;
            const int k2 = last ? 0 : t + 2;
            if constexpr (GATHER) { if (last) {
#pragma unroll
                for (int i_ = 0; i_ < 2; ++i_) gqc[0][i_] = (unsigned)gtab[un * BM + rA[i_]] * (unsigned)rstep + cA2[i_]; } }
            PG8_LDB(B0, 0, 0); PG8_LDB(B1, 0, 1); PG8_SCHED; PG8_LDA(At, 0, 0); PG8_STAGE_A(PG8_SA(1, 1), a1, 1, t + 1, gqc);
            if constexpr (GATHER) { if (last) {
#pragma unroll
                for (int i_ = 0; i_ < 2; ++i_) gqc[1][i_] = (unsigned)gtab[un * BM + HALF + rA[i_]] * (unsigned)rstep + cA2[i_]; } }
            PG8_WAIT_V(8); PG8_WAIT_L(0); PG8_BAR; PG8_MMA(0, 0, At, B0); PG8_MMA(0, 1, At, B1); PG8_BAR; PG8_SCHED;
            PG8_LDA(At, 0, 1); PG8_STAGE(PG8_SB(0, 0), b2, voffB); PG8_STAGE(PG8_SB(0, 1), b2 + hstep, voffB); PG8_STAGE_A(PG8_SA(0, 0), a2, 0, k2, gqc);
            PG8_WAIT_V(8); PG8_WAIT_L(0); PG8_BAR; PG8_MMA(1, 0, At, B0); PG8_MMA(1, 1, At, B1); PG8_BAR; PG8_SCHED;
            PG8_LDB(B0, 1, 0); PG8_LDB(B1, 1, 1); PG8_SCHED; PG8_LDA(At, 1, 0); PG8_STAGE_A(PG8_SA(0, 1), a2, 1, k2, gqc);
            PG8_WAIT_V(8); PG8_WAIT_L(0); PG8_BAR; PG8_MMA(0, 0, At, B0); PG8_MMA(0, 1, At, B1); PG8_BAR; PG8_SCHED;
            PG8_LDA(At, 1, 1); PG8_STAGE(PG8_SB(1, 0), b3, voffB); PG8_STAGE(PG8_SB(1, 1), b3 + hstep, voffB); PG8_STAGE_A(PG8_SA(1, 0), a3, 0, k2 + 1, gqc);
            PG8_WAIT_V(8); PG8_WAIT_L(0); PG8_BAR; PG8_MMA(1, 0, At, B0); PG8_MMA(1, 1, At, B1); PG8_BAR; PG8_SCHED;
        }
        if (wr == 0) PG8_BAR;
        E(acc, cur, wr, wc, fr, fq);
        if (!has_next) break;
        E.init(acc, nxt, wc, fq);
        cur = nxt; cA = nA; cB = nB; ++ui;
        if (wr == 1) PG8_BAR;
    }
    PG8_WAIT_V(0);
    PG8_BAR;
#undef PG8_SA
#undef PG8_CAT
#undef PG8_SB
#undef PG8_STAGE
#undef PG8_STAGE_A
#undef PG8_GLOAD
#undef PG8_LDA
#undef PG8_LDB
#undef PG8_MMA
#undef PG8_WAIT_V
#undef PG8_WAIT_L
#undef PG8_BAR
#undef PG8_SCHED
}
}

#define XB_TMO      128
#define XB_XCNT(j)  (256  + 64 * (j))
#define XB_XSUB(j)  (1280 + 64 * (j))
#define XB_XGEN(j)  (2304 + 64 * (j))
#define XB_TOP      3328
#define XB_TOPGEN   3392
#define XCD_BAR_WORDS 3456
#define XB_SPIN_CAP (1u << 18)
__device__ __forceinline__ unsigned xb_ld(unsigned* p)              { return __hip_atomic_load(p, __ATOMIC_RELAXED, __HIP_MEMORY_SCOPE_AGENT); }
__device__ __forceinline__ unsigned xb_add(unsigned* p, unsigned v) { return __hip_atomic_fetch_add(p, v, __ATOMIC_RELAXED, __HIP_MEMORY_SCOPE_AGENT); }
__device__ __forceinline__ unsigned xb_xcc_id() { return (unsigned)__builtin_amdgcn_s_getreg((3 << 11) | 20) & 0xFu; }
#define XB_SPIN(cond, bar) do { unsigned _sp = 0; while (cond) { __builtin_amdgcn_s_sleep(1); \
    if ((++_sp & 255u) == 0u) { if (xb_ld(&(bar)[XB_TMO])) break; if (_sp > XB_SPIN_CAP) { atomicAdd(&(bar)[XB_TMO], 1u); break; } } } } while (0)
struct XcdBarrier { unsigned* bar; unsigned x; volatile LAS unsigned* st; };
__device__ __forceinline__ XcdBarrier xcd_barrier_post(unsigned* bar, volatile LAS unsigned* st) {
    XcdBarrier b; b.bar = bar; b.x = xb_xcc_id(); b.st = st;
    if (threadIdx.x == 0) (void)xb_add(&bar[XB_XCNT(b.x)], 1u);
    return b;
}
__device__ __forceinline__ void xcd_barrier_complete(unsigned* bar, unsigned x, unsigned& nloc, unsigned& nx) {
    const unsigned G = gridDim.x * gridDim.y * gridDim.z;
    unsigned sum, cnt, mine, sp = 0u;
    for (;;) {
        sum = 0u; cnt = 0u; mine = 0u;
#pragma unroll
        for (unsigned j = 0; j < 16; ++j) { const unsigned c = xb_ld(&bar[XB_XCNT(j)]); sum += c; cnt += (c > 0u) ? 1u : 0u; mine = (j == x) ? c : mine; }
        if (sum == G) break;
        __builtin_amdgcn_s_sleep(1);
        if ((++sp & 255u) == 0u) { if (xb_ld(&bar[XB_TMO])) break; if (sp > XB_SPIN_CAP) { atomicAdd(&bar[XB_TMO], 1u); break; } }
    }
    nloc = mine > 0u ? mine : 1u; nx = cnt > 0u ? cnt : 1u;
}
__device__ __forceinline__ void xcd_barrier(const XcdBarrier& b) {
    asm volatile("s_waitcnt vmcnt(0)" ::: "memory");
    __syncthreads();
    if (threadIdx.x == 0) {
        unsigned* bar = b.bar;
        __builtin_amdgcn_s_waitcnt(0);
        unsigned nloc = b.st[0], nx = b.st[1];
        if (nloc == 0u) { xcd_barrier_complete(bar, b.x, nloc, nx); b.st[0] = nloc; b.st[1] = nx; }
        const unsigned old = xb_add(&bar[XB_XSUB(b.x)], 1u);
        const unsigned gen = old / nloc;
        if (old + 1u == (gen + 1u) * nloc) {
            __builtin_amdgcn_fence(__ATOMIC_RELEASE, "agent");
            asm volatile("s_waitcnt vmcnt(0)" ::: "memory");
            const unsigned og = xb_add(&bar[XB_TOP], 1u);
            const unsigned tg = og / nx;
            if (og + 1u == (tg + 1u) * nx) xb_add(&bar[XB_TOPGEN], 1u);
            else XB_SPIN(xb_ld(&bar[XB_TOPGEN]) == tg, bar);
            __builtin_amdgcn_fence(__ATOMIC_ACQUIRE, "agent");
            xb_add(&bar[XB_XGEN(b.x)], 1u);
            asm volatile("s_waitcnt vmcnt(0)" ::: "memory");
        } else {
            XB_SPIN(xb_ld(&bar[XB_XGEN(b.x)]) == gen, bar);
            __builtin_amdgcn_fence(__ATOMIC_ACQUIRE, "agent");
            asm volatile("s_waitcnt vmcnt(0)" ::: "memory");
        }
    }
    __syncthreads();
}

#define GRID_SYNC() do { XcdBarrier b_; b_.bar = (unsigned*)(kargs()->ws + WS_CTL) + CW_BAR; b_.x = xb_xcc_id(); b_.st = (volatile LAS unsigned*)((LAS unsigned char*)lds + MISC_OFF) + 8; xcd_barrier(b_); } while (0)
struct Frame {
    LAS unsigned char* lds; unsigned char* ldsg;
    int tid, lane, wave, vcu, G;
};
__device__ __forceinline__ int opaque_tid() { int t = threadIdx.x; asm volatile("" : "+v"(t)); return t; }
__device__ __forceinline__ Frame refresh(const Frame& Fi) { Frame F; F.lds = Fi.lds; F.ldsg = Fi.ldsg; F.tid = opaque_tid(); F.lane = F.tid & 63; F.wave = __builtin_amdgcn_readfirstlane(F.tid >> 6);
    int g = (int)gridDim.x, bx = (int)blockIdx.x; asm volatile("" : "+s"(g), "+s"(bx)); F.G = g; F.vcu = (g % 8 == 0) ? (bx % 8) * (g / 8) + bx / 8 : bx; return F; }
__device__ __forceinline__ float wave_sum(float v) {
#pragma unroll
    for (int o = 1; o < 64; o <<= 1) v += __shfl_xor(v, o);
    return v;
}
__device__ __forceinline__ void transpose_item(const float* W, int K, int N, bf16_t* WT, int row_off, LAS float* scr, int k0, int n0, int lane) {
    { const int r8 = lane >> 3, c4 = (lane & 7) * 4;
      f32x4 v[8];
#pragma unroll
      for (int i = 0; i < 8; ++i) v[i] = *(const GAS f32x4*)(W + (size_t)(k0 + 8 * i + r8) * N + n0 + c4);
#pragma unroll
      for (int i = 0; i < 8; ++i) { LAS float* d = scr + (8 * i + r8) * 33 + c4; d[0] = v[i].x; d[1] = v[i].y; d[2] = v[i].z; d[3] = v[i].w; } }
    LDS_WAIT(); asm volatile("" ::: "memory");
    const int c = lane & 7;
#pragma unroll
    for (int j = 0; j < 4; ++j) { const int n = (lane >> 3) + 8 * j; const LAS float* s = scr + (8 * c) * 33 + n;
        u32x4 o; o.x = pk2(s[0 * 33], s[1 * 33]); o.y = pk2(s[2 * 33], s[3 * 33]); o.z = pk2(s[4 * 33], s[5 * 33]); o.w = pk2(s[6 * 33], s[7 * 33]);
        *(GAS u32x4*)(WT + (size_t)(row_off + n0 + n) * K + k0 + 8 * c) = o; }
    LDS_WAIT(); asm volatile("" ::: "memory");
}
__device__ __forceinline__ void transpose_item_f8(const float* W, int K, int N, unsigned char* WT, int row_off, float scale, LAS float* scr, int k0, int n0, int lane) {
    { const int r8 = lane >> 3, c4 = (lane & 7) * 4;
      f32x4 v[8];
#pragma unroll
      for (int i = 0; i < 8; ++i) v[i] = *(const GAS f32x4*)(W + (size_t)(k0 + 8 * i + r8) * N + n0 + c4);
#pragma unroll
      for (int i = 0; i < 8; ++i) { LAS float* d = scr + (8 * i + r8) * 33 + c4; d[0] = v[i].x * scale; d[1] = v[i].y * scale; d[2] = v[i].z * scale; d[3] = v[i].w * scale; } }
    LDS_WAIT(); asm volatile("" ::: "memory");
    const int c = lane & 7;
#pragma unroll
    for (int j = 0; j < 4; ++j) { const int n = (lane >> 3) + 8 * j; const LAS float* s = scr + (8 * c) * 33 + n;
        u32x2 o; o.x = pk4_fp8(s[0 * 33], s[1 * 33], s[2 * 33], s[3 * 33]); o.y = pk4_fp8(s[4 * 33], s[5 * 33], s[6 * 33], s[7 * 33]);
        *(GAS u32x2*)(WT + (size_t)(row_off + n0 + n) * K + k0 + 8 * c) = o; }
    LDS_WAIT(); asm volatile("" ::: "memory");
}
__device__ __forceinline__ void convert_experts(const Frame& Fi, const float* wg, const float* wu, const float* wd, bf16_t* WGU, bf16_t* WDN) {
    Frame F = refresh(Fi);
    LAS float* scr = (LAS float*)(F.lds + F.wave * 16384);
    const int gw = F.vcu * NWAVES + F.wave, NGW = F.G * NWAVES;
    constexpr int IPM = (D / 64) * (D / 32);
    for (int it = gw; it < NE * 3 * IPM; it += NGW) {
        const int e = it / (3 * IPM), r = it % (3 * IPM), which = r / IPM, q = r % IPM, kb = q / (D / 32), nb = q % (D / 32), k0 = 64 * kb, n0 = 32 * nb;
        if (which == 2) transpose_item_f8(wd + (size_t)e * D * D, D, D, (unsigned char*)WDN + (size_t)e * D * D, 0, pg8::F8_SW, scr, k0, n0, F.lane);
        else { const int pn = n0 >> 7, dst0 = pn * 256 + which * 128 + (n0 & 127);
            transpose_item_f8((which ? wu : wg) + (size_t)e * D * D, D, D, (unsigned char*)WGU + (size_t)e * 2 * D * D, dst0 - n0, pg8::F8_SG, scr, k0, n0, F.lane); }
    }
}
__device__ __forceinline__ void load_row(const float* xrow, int lane, f32x4 (&v)[4]) {
    const GAS f32x4* xr = (const GAS f32x4*)xrow + lane;
#pragma unroll
    for (int j = 0; j < 4; ++j) v[j] = xr[64 * j];
}
__device__ __forceinline__ void load_row16(const bf16_t* xrow, int lane, u32x2 (&v)[4]) {
    const GAS u32x2* xr = (const GAS u32x2*)xrow + lane;
#pragma unroll
    for (int j = 0; j < 4; ++j) v[j] = xr[64 * j];
}
__device__ __forceinline__ f32x4 up4(const u32x2 w) { return (f32x4){__builtin_bit_cast(float, w.x << 16), __builtin_bit_cast(float, w.x & 0xffff0000u), __builtin_bit_cast(float, w.y << 16), __builtin_bit_cast(float, w.y & 0xffff0000u)}; }
__device__ __forceinline__ float row_rstd(const f32x4 (&v)[4]) {
    float s = 0.f;
#pragma unroll
    for (int j = 0; j < 4; ++j) s += (v[j].x * v[j].x + v[j].y * v[j].y) + (v[j].z * v[j].z + v[j].w * v[j].w);
    return 1.0f / sqrtf(wave_sum(s) * (1.f / D) + EPS);
}
__device__ __forceinline__ void load_gain(const float* gain, int lane, f32x4 (&g)[4]) {
#pragma unroll
    for (int j = 0; j < 4; ++j) g[j] = *((const GAS f32x4*)gain + lane + 64 * j);
}
__device__ __forceinline__ void store_row_bf16(bf16_t* orow, int lane, const f32x4 (&v)[4], const f32x4 (&g)[4], float rstd) {
    GAS unsigned long long* o8 = (GAS unsigned long long*)orow + lane;
#pragma unroll
    for (int j = 0; j < 4; ++j)
        o8[64 * j] = (unsigned long long)pk2(v[j].x * rstd * g[j].x, v[j].y * rstd * g[j].y) | ((unsigned long long)pk2(v[j].z * rstd * g[j].z, v[j].w * rstd * g[j].w) << 32);
}

__device__ __forceinline__ void vt_phase(const Frame& Fi, const bf16_t* qkvp, unsigned char* vt) {
    Frame F = refresh(Fi);
    const int lane = F.lane;
    LAS unsigned char* scr = F.lds + F.wave * 16384;
    for (int tile = F.vcu * NWAVES + F.wave; tile < BATCH * NH * (SEQ / 64); tile += F.G * NWAVES) {
        const int bh = tile >> 7, t = tile & 127, b = bh >> 2, h = bh & 3;
        const bf16_t* src = qkvp + ((size_t)b * SEQ + 64 * t) * INW + 1024 + h * 128;
        unsigned char* dst = vt + (size_t)tile * 8192;
#pragma unroll 1
        for (int part = 0; part < 2; ++part) {
            u32x4 v[8];
#pragma unroll
            for (int i = 0; i < 8; ++i) { const int pc = lane + 64 * i; v[i] = *(const u32x4*)(src + (size_t)(32 * part + (pc >> 4)) * INW + (pc & 15) * 8); }
#pragma unroll
            for (int i = 0; i < 8; ++i) { const int pc = lane + 64 * i; *(LAS u32x4*)(scr + (pc >> 4) * 272 + (pc & 15) * 16) = v[i]; }
            LDS_WAIT(); asm volatile("" ::: "memory");
#pragma unroll
            for (int dd = 0; dd < 2; ++dd) { const int dv = lane + 64 * dd; unsigned wd[8];
#pragma unroll
                for (int g = 0; g < 8; ++g) { float f[4];
#pragma unroll
                    for (int j = 0; j < 4; ++j) f[j] = __builtin_bit_cast(float, (unsigned)(*(const LAS unsigned short*)(scr + (4 * g + j) * 272 + dv * 2)) << 16) * 16.0f;
                    wd[g] = pk4_fp8(f[0], f[1], f[2], f[3]); }
                const int sw = (dv >> 2) & 3;
                *(u32x4*)(dst + dv * 64 + (((0 + part) ^ sw) << 4)) = (u32x4){wd[0], wd[2], wd[4], wd[6]};
                *(u32x4*)(dst + dv * 64 + (((2 + part) ^ sw) << 4)) = (u32x4){wd[1], wd[3], wd[5], wd[7]}; }
            LDS_WAIT(); asm volatile("" ::: "memory");
        }
    }
}

namespace att {
constexpr int PITCH = INW, NT = SEQ / 64, SLOTB = 32768, VOFF = 16384;
constexpr int L_V = 65536, L_ONES = 98304, L_LUT = 100352, L_WSF = 102400, L_STG = 65536;
constexpr float THR = 8.0f;
__device__ __forceinline__ int crow(int r, int hi) { return (r & 3) + 8 * (r >> 2) + 4 * hi; }
__device__ __forceinline__ void glds16(const void* sbase, unsigned voff, unsigned lds_dst) { unsigned keep;
    asm volatile("s_mov_b32 %0, m0\n\ts_mov_b32 m0, %3\n\ts_nop 0\n\tglobal_load_lds_dwordx4 %1, %2\n\ts_mov_b32 m0, %0" : "=&s"(keep) : "v"(voff), "s"(sbase), "s"(lds_dst) : "memory"); }
#define ATT_WAIT_BAR() asm volatile("s_waitcnt vmcnt(0) lgkmcnt(0)\n\ts_barrier" ::: "memory")
#define ATT_BAR() asm volatile("s_waitcnt lgkmcnt(0)\n\ts_barrier" ::: "memory")
__device__ __forceinline__ s16x4 vtr(const LAS char* p) { return __builtin_bit_cast(s16x4, __builtin_amdgcn_ds_read_tr16_b64_v4i16((LAS s16x4*)p)); }
__device__ __forceinline__ int rel_bucket(int rel) {
    const int ret = rel > 0 ? 16 : 0; const int n = rel < 0 ? -rel : rel;
    if (n < 8) return ret + n;
    int j = 0; while (j < 7 && 64 * (2 << j) <= n * n) ++j;
    return ret + 8 + j;
}
__device__ __forceinline__ void qkt(f32x16& p0, f32x16& p1, const LAS char* kb, const bf16x8 (&qr)[4], const f32x16& cin) {
#pragma unroll
    for (int d0 = 0; d0 < 4; ++d0) {
        const bf16x8 b0 = *(const LAS bf16x8*)(kb + d0 * 2048);
        const bf16x8 b1 = *(const LAS bf16x8*)(kb + d0 * 2048 + 512);
        if (d0 == 0) { p0 = __builtin_amdgcn_mfma_f32_32x32x16_bf16(b0, qr[0], cin, 0, 0, 0); p1 = __builtin_amdgcn_mfma_f32_32x32x16_bf16(b1, qr[0], cin, 0, 0, 0); }
        else { p0 = __builtin_amdgcn_mfma_f32_32x32x16_bf16(b0, qr[d0], p0, 0, 0, 0); p1 = __builtin_amdgcn_mfma_f32_32x32x16_bf16(b1, qr[d0], p1, 0, 0, 0); }
    }
}
#define MX3(a, b, c) __builtin_fmaxf(__builtin_fmaxf((a), (b)), (c))
__device__ __forceinline__ float rowmax(const f32x16& p0, const f32x16& p1) {
    float a = MX3(p0[0], p0[1], p1[0]), b = MX3(p0[2], p0[3], p1[1]); a = MX3(a, p1[2], p1[3]);
#pragma unroll
    for (int r = 4; r < 16; r += 4) { a = MX3(a, p0[r], p0[r + 1]); b = MX3(b, p0[r + 2], p0[r + 3]); a = MX3(a, p1[r], p1[r + 1]); b = MX3(b, p1[r + 2], p1[r + 3]); }
    float rm = __builtin_fmaxf(a, b);
    auto rr = __builtin_amdgcn_permlane32_swap(__float_as_uint(rm), __float_as_uint(rm), false, false);
    return __builtin_fmaxf(__uint_as_float(rr[0]), __uint_as_float(rr[1]));
}
__device__ __forceinline__ void attn_unit(int b, int h, int qb, const bf16_t* __restrict__ qkvp, const unsigned char* __restrict__ vt, bf16_t* mix, unsigned char* shm, const float* rel_table, float lam, const float* subg, float oscale) {
    int tid_ = threadIdx.x; asm volatile("" : "+v"(tid_));
    const int tid = tid_, lane = tid & 63, r32 = lane & 31, hi = lane >> 5;
    const int wid = __builtin_amdgcn_readfirstlane(tid >> 6), wq = wid >> 1, mp = wid & 1;
    const long rowbase = (long)b * SEQ; const int q0 = qb * 128;
    const unsigned lds0 = (unsigned)(uintptr_t)shm;
    LAS unsigned char* shm3 = (LAS unsigned char*)shm;
    LAS float* lut = (LAS float*)(shm3 + L_LUT);
    LAS float* wsf = (LAS float*)(shm3 + L_WSF) + wid * 64;
    const float lutv = rel_table[rel_bucket(min(tid, 446) - 223) * NH + h];
    const float cL = rel_table[15 * NH + h] * LOG2E, cR = rel_table[31 * NH + h] * LOG2E;
    const bf16_t* Qw = qkvp + (rowbase + q0 + wq * 32 + r32) * PITCH + h * 128 + mp * 64;
    bf16x8 qr[4];
#pragma unroll
    for (int d0 = 0; d0 < 4; ++d0) qr[d0] = *(const bf16x8*)(Qw + d0 * 16 + hi * 8);
    const bf16_t* ksrc = qkvp + rowbase * PITCH + 512 + h * 128 + wid * 8;
    const unsigned char* vsrc = vt + (size_t)((b * NH + h) * NT) * 8192 + wid * 1024;
    const unsigned kvo = (unsigned)lane * PITCH * 2u, vvo = (unsigned)lane * 16u;
    const unsigned dst0 = lds0 + wid * 1024;
#define ATT_ISSUE_K(t) do { const bf16_t* ks_ = ksrc + (long)(t) * 64 * PITCH; const unsigned d_ = (unsigned)__builtin_amdgcn_readfirstlane(dst0 + ((t) & 3) * 16384); glds16(ks_, kvo, d_); glds16(ks_ + 64, kvo, d_ + 8192); } while (0)
#define ATT_ISSUE_K1(t, pc) do { const bf16_t* ks_ = ksrc + (long)(t) * 64 * PITCH + (pc) * 64; const unsigned d_ = (unsigned)__builtin_amdgcn_readfirstlane(dst0 + ((t) & 3) * 16384 + (pc) * 8192); glds16(ks_, kvo, d_); } while (0)
#define ATT_ISSUE_V1(t, pc) do { if ((pc) == 0) { const unsigned char* vs_ = vsrc + (size_t)(t) * 8192; const unsigned d_ = (unsigned)__builtin_amdgcn_readfirstlane(dst0 + L_V + ((t) & 3) * 8192); glds16(vs_, vvo, d_); } } while (0)
#define ATT_ISSUE_V(t) ATT_ISSUE_V1(t, 0)
    const LAS char* kp0 = (const LAS char*)shm3 + mp * 8192 + hi * 1024 + r32 * 16;
    const LAS char* vp0 = (const LAS char*)shm3 + L_V + r32 * 64 + (((2 * hi) ^ ((r32 >> 2) & 3)) << 4);
    const LAS char* vq0 = (const LAS char*)shm3 + L_V + r32 * 64 + (((2 * hi + 1) ^ ((r32 >> 2) & 3)) << 4);
    const LAS char* vo0 = (const LAS char*)shm3 + L_ONES + r32 * 64;
    f32x16 o[5];
#pragma unroll
    for (int d = 0; d < 5; ++d)
#pragma unroll
        for (int r = 0; r < 16; ++r) o[d][r] = 0.f;
    float m_run = 0.f;
    const int qlo = q0 + wq * 32, qq = qlo + r32;
    f32x16 negm;
    float ct_cur;
    bool resc;
#define ATT_CLASS(t) ((64 * (t) + 63 - qlo <= -128) ? 0 : ((64 * (t) - (qlo + 31) >= 128) ? 2 : 1))
#define ATT_LUTADD(S0, S1, t) do { asm volatile("" ::: "memory");     \
        const LAS float* lb_ = lut + (64 * (t) + 4 * hi - qq + 223);          \
        _Pragma("unroll") for (int r = 0; r < 16; ++r) { S0[r] += lb_[(r & 3) + 8 * (r >> 2)]; S1[r] += lb_[(r & 3) + 8 * (r >> 2) + 32]; } } while (0)
#define SBAR() __builtin_amdgcn_sched_barrier(0)
#define ATT_VRD8(d) do { if ((d) == 4) { vf8[0][0] = *(const LAS u32x4*)(vo0); vf8[0][1] = *(const LAS u32x4*)(vo0 + 16); } else { vf8[(d) & 1][0] = *(const LAS u32x4*)(vp_ + (d) * 2048); vf8[(d) & 1][1] = *(const LAS u32x4*)(vq_ + (d) * 2048); } } while (0)
#define ATT_CAT8(x0, x1) __builtin_bit_cast(i32x8, __builtin_shufflevector(x0, x1, 0, 1, 2, 3, 4, 5, 6, 7))
#define ATT_PV8(d) do { const i32x8 a8_ = ATT_CAT8(p8a, p8b), b8_ = ATT_CAT8(vf8[(d) & 1][0], vf8[(d) & 1][1]); \
        asm volatile("v_mfma_scale_f32_32x32x64_f8f6f4 %0, %1, %2, %0, %3, %3 op_sel_hi:[0,0,0]" : "+v"(o[d]) : "v"(a8_), "v"(b8_), "v"(f8one)); } while (0)
#define ATT_KRD(j) do { kfr[(j) % 3] = *(const LAS bf16x8*)(kq_ + ((j) >> 1) * 2048 + ((j) & 1) * 512); } while (0)
#define ATT_STEP(C0, C1, N0, N1, t, HASQK) do { \
        const int cls_ = ATT_CLASS((t) + 1); const float ctn_ = cls_ == 0 ? cL : (cls_ == 2 ? cR : 0.f); \
        if (HASQK) { if (ctn_ != ct_cur) { asm volatile("" ::: "memory"); const float cm_ = ctn_ - m_run;     \
            _Pragma("unroll") for (int r = 0; r < 16; ++r) negm[r] = cm_; \
            ct_cur = ctn_; } } \
        const LAS char* kq_ = kp0 + (((t) + 1) & 3) * 16384; const LAS char* vp_ = vp0 + (((t) - 1) & 3) * 8192; const LAS char* vq_ = vq0 + (((t) - 1) & 3) * 8192; \
        float ra_ = 0.f, rb_ = 0.f; \
        ATT_VRD8(0); ATT_VRD8(1); if (HASQK) { ATT_KRD(0); ATT_KRD(1); } \
        __builtin_amdgcn_s_setprio(1); SBAR(); \
        ATT_PV8(0); ATT_VRD8(2); C0[0] = __builtin_amdgcn_exp2f(C0[0]); C0[1] = __builtin_amdgcn_exp2f(C0[1]); asm volatile("" : "+v"(C0[0])); asm volatile("" : "+v"(C0[1])); if ((t) + 3 < NT) ATT_ISSUE_K1((t) + 3, 0); SBAR(); \
        if (HASQK) { N0 = __builtin_amdgcn_mfma_f32_32x32x16_bf16(kfr[0], qr[0], negm, 0, 0, 0); ATT_KRD(2); } SBAR(); \
        ATT_PV8(1); ATT_VRD8(3); C0[2] = __builtin_amdgcn_exp2f(C0[2]); C0[3] = __builtin_amdgcn_exp2f(C0[3]); asm volatile("" : "+v"(C0[2])); asm volatile("" : "+v"(C0[3])); if ((t) + 1 < NT) ATT_ISSUE_V1((t) + 1, 0); SBAR(); \
        if (HASQK) { N1 = __builtin_amdgcn_mfma_f32_32x32x16_bf16(kfr[1], qr[0], negm, 0, 0, 0); ATT_KRD(3); } SBAR(); \
        ATT_PV8(2); ATT_VRD8(4); C0[4] = __builtin_amdgcn_exp2f(C0[4]); C0[5] = __builtin_amdgcn_exp2f(C0[5]); asm volatile("" : "+v"(C0[4])); asm volatile("" : "+v"(C0[5])); if ((t) + 3 < NT) ATT_ISSUE_K1((t) + 3, 1); SBAR(); \
        if (HASQK) { N0 = __builtin_amdgcn_mfma_f32_32x32x16_bf16(kfr[2], qr[1], N0, 0, 0, 0); ATT_KRD(4); } SBAR(); \
        ATT_PV8(3); ATT_PV8(4); C0[6] = __builtin_amdgcn_exp2f(C0[6]); C0[7] = __builtin_amdgcn_exp2f(C0[7]); asm volatile("" : "+v"(C0[6])); asm volatile("" : "+v"(C0[7]));  SBAR(); \
        if (HASQK) { N1 = __builtin_amdgcn_mfma_f32_32x32x16_bf16(kfr[0], qr[1], N1, 0, 0, 0); ATT_KRD(5); } SBAR(); \
        C0[8] = __builtin_amdgcn_exp2f(C0[8]); C0[9] = __builtin_amdgcn_exp2f(C0[9]); asm volatile("" : "+v"(C0[8])); asm volatile("" : "+v"(C0[9])); p8a[0] = (unsigned)__builtin_amdgcn_cvt_pk_fp8_f32(C0[0], C0[1], (int)p8a[0], false); SBAR(); \
        if (HASQK) { N0 = __builtin_amdgcn_mfma_f32_32x32x16_bf16(kfr[1], qr[2], N0, 0, 0, 0); ATT_KRD(6); } SBAR(); \
        C0[10] = __builtin_amdgcn_exp2f(C0[10]); C0[11] = __builtin_amdgcn_exp2f(C0[11]); asm volatile("" : "+v"(C0[10])); asm volatile("" : "+v"(C0[11])); p8a[0] = (unsigned)__builtin_amdgcn_cvt_pk_fp8_f32(C0[2], C0[3], (int)p8a[0], true); SBAR(); \
        if (HASQK) { N1 = __builtin_amdgcn_mfma_f32_32x32x16_bf16(kfr[2], qr[2], N1, 0, 0, 0); ATT_KRD(7); } SBAR(); \
        C0[12] = __builtin_amdgcn_exp2f(C0[12]); C0[13] = __builtin_amdgcn_exp2f(C0[13]); asm volatile("" : "+v"(C0[12])); asm volatile("" : "+v"(C0[13])); p8a[1] = (unsigned)__builtin_amdgcn_cvt_pk_fp8_f32(C0[4], C0[5], (int)p8a[1], false); SBAR(); \
        if (HASQK) { N0 = __builtin_amdgcn_mfma_f32_32x32x16_bf16(kfr[0], qr[3], N0, 0, 0, 0); } SBAR(); \
        C0[14] = __builtin_amdgcn_exp2f(C0[14]); C0[15] = __builtin_amdgcn_exp2f(C0[15]); asm volatile("" : "+v"(C0[14])); asm volatile("" : "+v"(C0[15])); p8a[1] = (unsigned)__builtin_amdgcn_cvt_pk_fp8_f32(C0[6], C0[7], (int)p8a[1], true); SBAR(); \
        if (HASQK) { N1 = __builtin_amdgcn_mfma_f32_32x32x16_bf16(kfr[1], qr[3], N1, 0, 0, 0); } __builtin_amdgcn_s_setprio(0); SBAR(); \
        if (HASQK) { if (cls_ == 1) ATT_LUTADD(N0, N1, (t) + 1); } SBAR(); \
        C1[0] = __builtin_amdgcn_exp2f(C1[0]); C1[1] = __builtin_amdgcn_exp2f(C1[1]); asm volatile("" : "+v"(C1[0])); asm volatile("" : "+v"(C1[1])); p8a[2] = (unsigned)__builtin_amdgcn_cvt_pk_fp8_f32(C0[8], C0[9], (int)p8a[2], false); if (HASQK) { ra_ = MX3(N0[0], N0[1], N1[0]); } if (HASQK) { rb_ = MX3(N0[2], N0[3], N1[1]); } if (HASQK) { asm volatile("" : "+v"(ra_), "+v"(rb_)); } SBAR(); \
        C1[2] = __builtin_amdgcn_exp2f(C1[2]); C1[3] = __builtin_amdgcn_exp2f(C1[3]); asm volatile("" : "+v"(C1[2])); asm volatile("" : "+v"(C1[3])); p8a[2] = (unsigned)__builtin_amdgcn_cvt_pk_fp8_f32(C0[10], C0[11], (int)p8a[2], true); if (HASQK) { ra_ = MX3(ra_, N1[2], N1[3]); } if (HASQK) { ra_ = MX3(ra_, N0[4], N0[5]); } if (HASQK) { asm volatile("" : "+v"(ra_), "+v"(rb_)); } SBAR(); \
        C1[4] = __builtin_amdgcn_exp2f(C1[4]); C1[5] = __builtin_amdgcn_exp2f(C1[5]); asm volatile("" : "+v"(C1[4])); asm volatile("" : "+v"(C1[5])); p8a[3] = (unsigned)__builtin_amdgcn_cvt_pk_fp8_f32(C0[12], C0[13], (int)p8a[3], false); if (HASQK) { rb_ = MX3(rb_, N0[6], N0[7]); } if (HASQK) { ra_ = MX3(ra_, N1[4], N1[5]); } if (HASQK) { asm volatile("" : "+v"(ra_), "+v"(rb_)); } SBAR(); \
        C1[6] = __builtin_amdgcn_exp2f(C1[6]); C1[7] = __builtin_amdgcn_exp2f(C1[7]); asm volatile("" : "+v"(C1[6])); asm volatile("" : "+v"(C1[7])); p8a[3] = (unsigned)__builtin_amdgcn_cvt_pk_fp8_f32(C0[14], C0[15], (int)p8a[3], true); if (HASQK) { rb_ = MX3(rb_, N1[6], N1[7]); } if (HASQK) { ra_ = MX3(ra_, N0[8], N0[9]); } if (HASQK) { asm volatile("" : "+v"(ra_), "+v"(rb_)); } SBAR(); \
        C1[8] = __builtin_amdgcn_exp2f(C1[8]); C1[9] = __builtin_amdgcn_exp2f(C1[9]); asm volatile("" : "+v"(C1[8])); asm volatile("" : "+v"(C1[9])); p8b[0] = (unsigned)__builtin_amdgcn_cvt_pk_fp8_f32(C1[0], C1[1], (int)p8b[0], false); if (HASQK) { rb_ = MX3(rb_, N0[10], N0[11]); } if (HASQK) { ra_ = MX3(ra_, N1[8], N1[9]); } if (HASQK) { asm volatile("" : "+v"(ra_), "+v"(rb_)); } SBAR(); \
        C1[10] = __builtin_amdgcn_exp2f(C1[10]); C1[11] = __builtin_amdgcn_exp2f(C1[11]); asm volatile("" : "+v"(C1[10])); asm volatile("" : "+v"(C1[11])); p8b[0] = (unsigned)__builtin_amdgcn_cvt_pk_fp8_f32(C1[2], C1[3], (int)p8b[0], true); if (HASQK) { rb_ = MX3(rb_, N1[10], N1[11]); } if (HASQK) { ra_ = MX3(ra_, N0[12], N0[13]); } if (HASQK) { asm volatile("" : "+v"(ra_), "+v"(rb_)); } SBAR(); \
        C1[12] = __builtin_amdgcn_exp2f(C1[12]); C1[13] = __builtin_amdgcn_exp2f(C1[13]); asm volatile("" : "+v"(C1[12])); asm volatile("" : "+v"(C1[13])); p8b[1] = (unsigned)__builtin_amdgcn_cvt_pk_fp8_f32(C1[4], C1[5], (int)p8b[1], false); if (HASQK) { rb_ = MX3(rb_, N0[14], N0[15]); } if (HASQK) { ra_ = MX3(ra_, N1[12], N1[13]); } if (HASQK) { asm volatile("" : "+v"(ra_), "+v"(rb_)); } SBAR(); \
        C1[14] = __builtin_amdgcn_exp2f(C1[14]); C1[15] = __builtin_amdgcn_exp2f(C1[15]); asm volatile("" : "+v"(C1[14])); asm volatile("" : "+v"(C1[15])); p8b[1] = (unsigned)__builtin_amdgcn_cvt_pk_fp8_f32(C1[6], C1[7], (int)p8b[1], true); if (HASQK) { rb_ = MX3(rb_, N1[14], N1[15]); } if (HASQK) { asm volatile("" : "+v"(ra_), "+v"(rb_)); } SBAR(); \
        p8b[2] = (unsigned)__builtin_amdgcn_cvt_pk_fp8_f32(C1[8], C1[9], (int)p8b[2], false); p8b[2] = (unsigned)__builtin_amdgcn_cvt_pk_fp8_f32(C1[10], C1[11], (int)p8b[2], true); p8b[3] = (unsigned)__builtin_amdgcn_cvt_pk_fp8_f32(C1[12], C1[13], (int)p8b[3], false); p8b[3] = (unsigned)__builtin_amdgcn_cvt_pk_fp8_f32(C1[14], C1[15], (int)p8b[3], true); \
        if (resc) { LDS_WAIT(); \
            _Pragma("unroll") for (int r = 0; r < 16; ++r) { const float fr_ = wsf[crow(r, hi)]; \
                _Pragma("unroll") for (int d = 0; d < 5; ++d) o[d][r] *= fr_; } } \
        resc = false; \
        if (HASQK) { float rm_ = __builtin_fmaxf(ra_, rb_); \
            { auto rr_ = __builtin_amdgcn_permlane32_swap(__float_as_uint(rm_), __float_as_uint(rm_), false, false); rm_ = __builtin_fmaxf(__uint_as_float(rr_[0]), __uint_as_float(rr_[1])); } \
            if (__any(rm_ > THR)) { const float dl_ = __builtin_fmaxf(rm_, 0.f); m_run += dl_; \
                _Pragma("unroll") for (int r = 0; r < 16; ++r) { N0[r] -= dl_; N1[r] -= dl_; negm[r] -= dl_; } \
                const float f_ = __builtin_amdgcn_exp2f(-dl_); if (hi == 0) wsf[r32] = f_; resc = true; } } \
    } while (0)
    int f8one = 0x7f7f7f7f; asm volatile("" : "+v"(f8one));
    f32x16 sA0, sA1, sB0, sB1; u32x4 p8a, p8b, vf8[2][2]; bf16x8 kfr[3];
    ATT_ISSUE_K(0); ATT_ISSUE_K(1);
    if (tid < 447) lut[tid] = lutv * LOG2E;
    if (tid < 128) { unsigned fill = (tid < 4) ? 0x38383838u : 0u; asm volatile("" : "+v"(fill));
        *(LAS u32x4*)(shm3 + L_ONES + tid * 16) = (u32x4){fill, fill, fill, fill}; }
    ATT_WAIT_BAR();
    ATT_ISSUE_K(2); ATT_ISSUE_K(3); ATT_ISSUE_V(0); ATT_ISSUE_V(1);
    {
        const int cls = ATT_CLASS(0); ct_cur = cls == 0 ? cL : (cls == 2 ? cR : 0.f);
#pragma unroll
        for (int r = 0; r < 16; ++r) negm[r] = ct_cur;
        qkt(sA0, sA1, kp0, qr, negm);
        if (cls == 1) ATT_LUTADD(sA0, sA1, 0);
        const float rm = rowmax(sA0, sA1); m_run = rm;
#pragma unroll
        for (int r = 0; r < 16; ++r) { sA0[r] = __builtin_amdgcn_exp2f(sA0[r] - rm); sA1[r] = __builtin_amdgcn_exp2f(sA1[r] - rm); }
#pragma unroll
        for (int i = 0; i < 4; ++i) { p8a[i] = pk4_fp8(sA0[4 * i], sA0[4 * i + 1], sA0[4 * i + 2], sA0[4 * i + 3]); p8b[i] = pk4_fp8(sA1[4 * i], sA1[4 * i + 1], sA1[4 * i + 2], sA1[4 * i + 3]); }
        const int cls1 = ATT_CLASS(1); ct_cur = cls1 == 0 ? cL : (cls1 == 2 ? cR : 0.f);
        { const float cm = ct_cur - m_run;
#pragma unroll
          for (int r = 0; r < 16; ++r) negm[r] = cm; }
        qkt(sB0, sB1, kp0 + 16384, qr, negm);
        if (cls1 == 1) ATT_LUTADD(sB0, sB1, 1);
        const float rm1 = rowmax(sB0, sB1); resc = false;
        if (__any(rm1 > THR)) { const float dl = __builtin_fmaxf(rm1, 0.f); m_run += dl;
#pragma unroll
            for (int r = 0; r < 16; ++r) { sB0[r] -= dl; sB1[r] -= dl; negm[r] -= dl; }
            const float f = __builtin_amdgcn_exp2f(-dl); if (hi == 0) wsf[r32] = f; resc = true; }
    }
    {
        int t = 1;
        for (; t + 2 < NT; t += 2) { ATT_WAIT_BAR(); ATT_STEP(sB0, sB1, sA0, sA1, t, true); ATT_STEP(sA0, sA1, sB0, sB1, t + 1, true); }
        ATT_WAIT_BAR(); ATT_STEP(sB0, sB1, sA0, sA1, t, false);
    }
    ATT_WAIT_BAR();
    {
        const LAS char* vp_ = vp0 + ((NT - 1) & 3) * 8192; const LAS char* vq_ = vq0 + ((NT - 1) & 3) * 8192;
        ATT_VRD8(0); ATT_VRD8(1);
        SBAR();
        ATT_PV8(0); ATT_VRD8(2); SBAR();
        ATT_PV8(1); ATT_VRD8(3); SBAR();
        ATT_PV8(2); ATT_VRD8(4); SBAR();
        ATT_PV8(3); SBAR();
        ATT_PV8(4); SBAR();
        asm volatile("s_nop 15\n\ts_nop 15\n\ts_nop 15\n\ts_nop 15" ::: "memory");
    }
    if (resc) { LDS_WAIT();
#pragma unroll
        for (int r = 0; r < 16; ++r) { const float fr_ = wsf[crow(r, hi)];
#pragma unroll
            for (int d = 0; d < 5; ++d) o[d][r] *= fr_; } }
#undef ATT_STEP
#undef ATT_KRD
#undef ATT_VRD8
#undef ATT_PV8
#undef ATT_CAT8
#undef SBAR
#undef ATT_LUTADD
#undef ATT_CLASS
#undef ATT_ISSUE_K
#undef ATT_ISSUE_K1
#undef ATT_ISSUE_V1
#undef ATT_ISSUE_V
    if (r32 == 0) {
#pragma unroll
        for (int r = 0; r < 16; ++r) wsf[32 + crow(r, hi)] = (1.0f / 16.0f) / o[4][r]; }
    LDS_WAIT();
#pragma unroll
    for (int r = 0; r < 16; ++r) { const float rl_ = wsf[32 + crow(r, hi)];
#pragma unroll
        for (int d = 0; d < 4; ++d) o[d][r] *= rl_; }
    ATT_BAR();
    LAS float* X = (LAS float*)shm3 + wq * 4096;
    if (mp == 1) {
#pragma unroll
        for (int d = 0; d < 4; ++d)
#pragma unroll
            for (int r = 0; r < 16; ++r) X[(d * 16 + r) * 64 + lane] = o[d][r];
    }
    ATT_BAR();
    if (mp == 0) {
#pragma unroll
        for (int d = 0; d < 4; ++d)
#pragma unroll
            for (int r = 0; r < 16; ++r) o[d][r] -= lam * X[(d * 16 + r) * 64 + lane];
        float gsc[4];
#pragma unroll
        for (int d = 0; d < 4; ++d) gsc[d] = subg[32 * d + r32] * oscale;
        LAS bf16_t* stg = (LAS bf16_t*)(shm3 + L_STG) + wq * 4096;
#pragma unroll
        for (int r = 0; r < 16; ++r) {
            float ss = (o[0][r] * o[0][r] + o[1][r] * o[1][r]) + (o[2][r] * o[2][r] + o[3][r] * o[3][r]);
#pragma unroll
            for (int x = 1; x < 32; x <<= 1) ss += __shfl_xor(ss, x);
            const float rstd = 1.0f / sqrtf(ss * (1.f / 128.f) + EPS);
#pragma unroll
            for (int d = 0; d < 4; ++d) stg[crow(r, hi) * 128 + 32 * d + r32] = (bf16_t)f2bf(o[d][r] * rstd * gsc[d]);
        }
        LDS_WAIT();
        bf16_t* Ow = mix + (rowbase + q0 + wq * 32) * D + h * 128;
#pragma unroll
        for (int i = 0; i < 8; ++i) { const int row = 4 * i + (lane >> 4), ch = lane & 15; const u32x4 v = *(const LAS u32x4*)(stg + row * 128 + ch * 8); *(u32x4*)(Ow + (long)row * D + ch * 8) = v; }
    }
    ATT_BAR();
}
}

template <int WIN>
__device__ __forceinline__ void pool_item(int g, int tok0, int lane, int r32, int hi, LAS unsigned char* st, const bf16_t* qkvp, const bf16_t* wpT, const float* pscale, bf16_t* mix) {
    constexpr int HALFW = WIN / 2, NR = 32 + WIN - 1, PITCH = 272;
    const int s0 = tok0 & (SEQ - 1);
    { const bf16_t* base = qkvp + (size_t)tok0 * INW + 1536 + g * 128 + 8 * (lane & 15);
      constexpr int NB = (NR + 3) / 4;
      u32x4 v[NB];
#pragma unroll
      for (int i = 0; i < NB; ++i) { const int ri = 4 * i + (lane >> 4), sp = min(max(s0 - HALFW + ri, 0), SEQ - 1);
          v[i] = *(const u32x4*)(base + (long)(sp - s0) * INW); }
#pragma unroll
      for (int i = 0; i < NB; ++i) { const int ri = 4 * i + (lane >> 4), sp = s0 - HALFW + ri;
          const bool ok = (sp >= 0 && sp < SEQ);
          u32x4 z; z.x = ok ? v[i].x : 0u; z.y = ok ? v[i].y : 0u; z.z = ok ? v[i].z : 0u; z.w = ok ? v[i].w : 0u;
          *(LAS u32x4*)(st + ri * PITCH + (lane & 15) * 16) = z; } }
    asm volatile("s_waitcnt lgkmcnt(0)" ::: "memory");
    const int s = s0 + r32;
    const int lo = max(s - HALFW, 0), hi_ = min(s - HALFW + WIN - 1, SEQ - 1);
    const float rc = 1.0f / (float)(hi_ - lo + 1);
    f32x16 acc[4];
#pragma unroll
    for (int cb = 0; cb < 4; ++cb)
#pragma unroll
        for (int r = 0; r < 16; ++r) acc[cb][r] = 0.f;
    const LAS unsigned char* lrow = st + r32 * PITCH + hi * 16;
#pragma unroll (WIN <= 4 ? 4 : (WIN == 8 ? 2 : 1))
    for (int ks = 0; ks < 8; ++ks) {
        bf16x8 bfr[4];
#pragma unroll
        for (int cb = 0; cb < 4; ++cb) bfr[cb] = *(const bf16x8*)(wpT + (size_t)(g * 128 + 32 * cb + r32) * 128 + 16 * ks + 8 * hi);
        float sum[8];
#pragma unroll
        for (int i = 0; i < 8; ++i) sum[i] = 0.f;
        u32x4 own;
#pragma unroll
        for (int j = 0; j < WIN; ++j) { const u32x4 v = *(const LAS u32x4*)(lrow + j * PITCH + 32 * ks); if (j == HALFW) own = v;
#pragma unroll
            for (int i = 0; i < 4; ++i) { sum[2 * i] += __builtin_bit_cast(float, v[i] << 16); sum[2 * i + 1] += __builtin_bit_cast(float, v[i] & 0xffff0000u); } }
        u32x4 aw;
#pragma unroll
        for (int i = 0; i < 4; ++i) { const float o0 = __builtin_bit_cast(float, own[i] << 16), o1 = __builtin_bit_cast(float, own[i] & 0xffff0000u);
            aw[i] = pk2(sum[2 * i] * rc - o0, sum[2 * i + 1] * rc - o1); }
        const bf16x8 af = __builtin_bit_cast(bf16x8, aw);
#pragma unroll
        for (int cb = 0; cb < 4; ++cb) acc[cb] = __builtin_amdgcn_mfma_f32_32x32x16_bf16(af, bfr[cb], acc[cb], 0, 0, 0);
    }
    asm volatile("s_waitcnt lgkmcnt(0)" ::: "memory");
#pragma unroll
    for (int cb = 0; cb < 4; ++cb) { const float ps = pscale[g * 128 + 32 * cb + r32];
#pragma unroll
        for (int r = 0; r < 16; ++r) { const int row = tok0 + (r & 3) + 8 * (r >> 2) + 4 * hi; mix[(size_t)row * D + 512 + g * 128 + 32 * cb + r32] = (bf16_t)f2bf(acc[cb][r] * ps); } }
}
__device__ __forceinline__ void pool_phase(const Frame& Fi, const bf16_t* qkvp, const bf16_t* wpT, const float* pscale, bf16_t* mix) {
    Frame F = refresh(Fi);
    const int lane = F.lane;
    const int gw = F.vcu * NWAVES + F.wave, NGW = F.G * NWAVES;
    LAS unsigned char* st = F.lds + F.wave * 16384;
    for (int it = gw; it < (NTOK / 32) * 4; it += NGW) {
        const int g = (it >= (NTOK / 32) * 2) ? 3 - (it & 3) : (it & 3), tok0 = (it >> 2) * 32;
        int r32 = lane & 31, hi = lane >> 5; asm volatile("" : "+v"(r32), "+v"(hi));
        if (g == 0) pool_item<2>(0, tok0, lane, r32, hi, st, qkvp, wpT, pscale, mix);
        else if (g == 1) pool_item<4>(1, tok0, lane, r32, hi, st, qkvp, wpT, pscale, mix);
        else if (g == 2) pool_item<8>(2, tok0, lane, r32, hi, st, qkvp, wpT, pscale, mix);
        else pool_item<16>(3, tok0, lane, r32, hi, st, qkvp, wpT, pscale, mix);
    }
}

__device__ __forceinline__ void router_phase(const Frame& Fi, const bf16_t* X, const float* g2, const float* wr, const float* br, unsigned* gcnt, int* tl, u32x2* gd, bf16_t* H2) {
    Frame F = refresh(Fi);
    const int lane = F.lane, w = F.wave, r32 = lane & 31, hi = lane >> 5;
    LAS unsigned char* xs = F.lds;
    LAS float* part = (LAS float*)(F.lds + 131584);
    LAS int* cntl = (LAS int*)(F.lds + 160256);
    LAS int* gbs = (LAS int*)(F.lds + 160384);
    LAS float* rs = (LAS float*)(F.lds + 160512);
    bf16x8 ap[8][3];
#pragma unroll
    for (int q = 0; q < 8; ++q) { unsigned pc[3][4];
#pragma unroll
        for (int i = 0; i < 8; ++i) { const int k = 128 * w + 16 * q + 8 * hi + i; const float a = wr[k * NE + r32] * g2[k];
            const unsigned b0 = __builtin_bit_cast(unsigned, a) & 0xffff0000u; const float r1 = a - __builtin_bit_cast(float, b0);
            const unsigned b1 = __builtin_bit_cast(unsigned, r1) & 0xffff0000u; const float r2 = r1 - __builtin_bit_cast(float, b1);
            const unsigned b2 = __builtin_bit_cast(unsigned, r2) & 0xffff0000u;
            if (i & 1) { pc[0][i >> 1] |= b0; pc[1][i >> 1] |= b1; pc[2][i >> 1] |= b2; } else { pc[0][i >> 1] = b0 >> 16; pc[1][i >> 1] = b1 >> 16; pc[2][i >> 1] = b2 >> 16; } }
#pragma unroll
        for (int c = 0; c < 3; ++c) ap[q][c] = __builtin_bit_cast(bf16x8, (u32x4){pc[c][0], pc[c][1], pc[c][2], pc[c][3]}); }
    u32x2 v[4][4];
    const f32x4 gq = *((const GAS f32x4*)g2 + 32 * w + r32);
    int item = F.vcu;
    if (item < NTOK / 32) {
#pragma unroll
        for (int q = 0; q < 4; ++q) load_row16(X + (size_t)(item * 32 + 4 * w + q) * D, lane, v[q]);
    }
    for (; item < NTOK / 32; item += F.G) {
        const int tok0 = item * 32;
        if (F.tid < 32) cntl[F.tid] = 0;
#pragma unroll
        for (int q = 0; q < 4; ++q) { const int r = 4 * w + q; float ss = 0.f;
#pragma unroll
            for (int j = 0; j < 4; ++j) { const f32x4 x = up4(v[q][j]); ss += (x.x * x.x + x.y * x.y) + (x.z * x.z + x.w * x.w);
                *(LAS f32x4*)(xs + r * 4096 + (((lane + 64 * j) ^ (r & 15)) << 4)) = x; }
            ss = wave_sum(ss);
            if (lane == 0) rs[r] = 1.0f / sqrtf(ss * (1.f / D) + EPS); }
        if (item + F.G < NTOK / 32) {
#pragma unroll
            for (int q = 0; q < 4; ++q) load_row16(X + (size_t)((item + F.G) * 32 + 4 * w + q) * D, lane, v[q]);
        }
        __syncthreads();
        f32x16 acc;
#pragma unroll
        for (int r = 0; r < 16; ++r) acc[r] = 0.f;
        { const LAS unsigned char* xr = xs + r32 * 4096;
#pragma unroll
          for (int q = 0; q < 8; ++q) { const int c = 32 * w + 4 * q + 2 * hi;
              const u32x4 x0 = *(const LAS u32x4*)(xr + ((c ^ (r32 & 15)) << 4)), x1 = *(const LAS u32x4*)(xr + (((c + 1) ^ (r32 & 15)) << 4));
              const bf16x8 xb = __builtin_bit_cast(bf16x8, (u32x4){__builtin_amdgcn_perm(x0.y, x0.x, 0x07060302u), __builtin_amdgcn_perm(x0.w, x0.z, 0x07060302u),
                                                                    __builtin_amdgcn_perm(x1.y, x1.x, 0x07060302u), __builtin_amdgcn_perm(x1.w, x1.z, 0x07060302u)});
#pragma unroll
              for (int pcs = 0; pcs < 3; ++pcs) acc = __builtin_amdgcn_mfma_f32_32x32x16_bf16(ap[q][pcs], xb, acc, 0, 0, 0); } }
        if (w > 0) {
#pragma unroll
            for (int r = 0; r < 16; ++r) part[((w - 1) * 16 + r) * 64 + lane] = acc[r]; }
        __syncthreads();
        if (w == 0) {
#pragma unroll
            for (int pw = 0; pw < 7; ++pw)
#pragma unroll
                for (int r = 0; r < 16; ++r) acc[r] += part[(pw * 16 + r) * 64 + lane];
            const float rstd = rs[r32];
            float lv4[16];
#pragma unroll
            for (int r = 0; r < 16; ++r) lv4[r] = acc[r] * rstd + br[(r & 3) + 8 * (r >> 2) + 4 * hi];
            float lv[4]; int le[4];
#pragma unroll
            for (int k = 0; k < 4; ++k) { float best = -INFINITY; int bi = 0;
#pragma unroll
                for (int r = 0; r < 16; ++r) { const bool gtb = lv4[r] > best; best = gtb ? lv4[r] : best; bi = gtb ? r : bi; }
                lv[k] = best; le[k] = (bi & 3) + 8 * (bi >> 2) + 4 * hi;
#pragma unroll
                for (int r = 0; r < 16; ++r) lv4[r] = (r == bi) ? -INFINITY : lv4[r]; }
            float cv[8]; int ce[8];
#pragma unroll
            for (int k = 0; k < 4; ++k) { cv[k] = lv[k]; ce[k] = le[k]; cv[4 + k] = __shfl_xor(lv[k], 32); ce[4 + k] = __shfl_xor(le[k], 32); }
            float tv[4], gt[4]; int te[4], lr[4] = {0, 0, 0, 0};
#pragma unroll
            for (int k = 0; k < 4; ++k) { float best = -INFINITY; int be = 1 << 20, bi = 0;
#pragma unroll
                for (int c = 0; c < 8; ++c) { const bool b = (cv[c] > best) || (cv[c] == best && ce[c] < be); best = b ? cv[c] : best; be = b ? ce[c] : be; bi = b ? c : bi; }
                tv[k] = best; te[k] = be;
#pragma unroll
                for (int c = 0; c < 8; ++c) cv[c] = (c == bi) ? -INFINITY : cv[c]; }
            float den = 0.f;
#pragma unroll
            for (int k = 0; k < 4; ++k) { gt[k] = __expf(tv[k] - tv[0]); den += gt[k]; }
#pragma unroll
            for (int k = 0; k < 4; ++k) gt[k] = gt[k] / den;
            if (hi == 0) {
#pragma unroll
                for (int k = 0; k < 4; ++k) lr[k] = __hip_atomic_fetch_add(cntl + te[k], 1, __ATOMIC_RELAXED, __HIP_MEMORY_SCOPE_WORKGROUP);
            }
            LDS_WAIT(); asm volatile("" ::: "memory");
            if (lane < 32) gbs[lane] = (int)__hip_atomic_fetch_add(gcnt + 64 * lane, (unsigned)cntl[lane], __ATOMIC_RELAXED, __HIP_MEMORY_SCOPE_AGENT);
            LDS_WAIT(); asm volatile("" ::: "memory");
            if (hi == 0) { const int tok = tok0 + r32;
#pragma unroll
                for (int k = 0; k < 4; ++k) { const int rk = gbs[te[k]] + lr[k]; tl[te[k] * NTOK + rk] = tok; gd[te[k] * NTOK + rk] = (u32x2){__builtin_bit_cast(unsigned, gt[k]), (unsigned)(tok * 4 + k)}; } }
        }
#pragma unroll
        for (int q = 0; q < 4; ++q)
#pragma unroll
            for (int j = 0; j < 4; ++j) asm volatile("" : "+v"(v[q][j].x), "+v"(v[q][j].y));
        { const int cc = 32 * w + r32;
#pragma unroll 4
          for (int i = 0; i < 16; ++i) { const int r = 2 * i + hi; const float rstd = rs[r];
              const f32x4 x = *(const LAS f32x4*)(xs + r * 4096 + ((cc ^ (r & 15)) << 4));
              const float rs_ = rstd * pg8::F8_SH;
              *((GAS unsigned*)((unsigned char*)H2 + (size_t)(tok0 + r) * D) + cc) = pk4_fp8(x.x * rs_ * gq.x, x.y * rs_ * gq.y, x.z * rs_ * gq.z, x.w * rs_ * gq.w); } }
        __syncthreads();
    }
}
__device__ __forceinline__ void build_tables(const Frame& Fi, unsigned* gcnt) {
    Frame F = refresh(Fi);
    LAS int* tab = (LAS int*)(F.lds + TAB_OFF);
    if (F.wave == 0) {
        const int c = (F.lane < NE) ? (int)__hip_atomic_load(gcnt + 64 * F.lane, __ATOMIC_RELAXED, __HIP_MEMORY_SCOPE_AGENT) : 0;
        const int tl = (c + 255) >> 8;
        int ps = c, pt = tl;
#pragma unroll
        for (int o = 1; o < 32; o <<= 1) { const int a = __shfl_up(ps, o), b = __shfl_up(pt, o); if (F.lane >= o) { ps += a; pt += b; } }
        if (F.lane < NE) { tab[F.lane + 1] = pt; tab[33 + F.lane + 1] = ps; tab[66 + F.lane] = c; }
        if (F.lane == 0) { tab[0] = 0; tab[33] = 0; }
    }
    __syncthreads();
}
__device__ __forceinline__ void combine_phase(const Frame& Fi, bf16_t* X, const bf16_t* y, const float* gain, bf16_t* hout, float* fout) {
    Frame F = refresh(Fi);
    const int gw = F.vcu * NWAVES + F.wave, NGW = F.G * NWAVES;
    f32x4 gn[4]; load_gain(gain, F.lane, gn);
    for (int tok0 = gw; tok0 < NTOK; tok0 += 2 * NGW) {
        f32x4 v[2][4]; u32x2 xv[2][4]; unsigned w[2][4][4];
#pragma unroll
        for (int q = 0; q < 2; ++q) { const int tok = min(tok0 + q * NGW, NTOK - 1); load_row16(X + (size_t)tok * D, F.lane, xv[q]);
#pragma unroll
            for (int k = 0; k < 4; ++k) { const GAS unsigned* yr = (const GAS unsigned*)((const unsigned char*)y + (size_t)(tok * 4 + k) * D) + F.lane;
#pragma unroll
                for (int j = 0; j < 4; ++j) w[q][k][j] = yr[64 * j]; } }
#pragma unroll
        for (int q = 0; q < 2; ++q) { const int tok = tok0 + q * NGW; if (tok >= NTOK) break;
#pragma unroll
            for (int j = 0; j < 4; ++j) v[q][j] = up4(xv[q][j]);
#pragma unroll
            for (int j = 0; j < 4; ++j) { f32x4 t = (f32x4){0.f, 0.f, 0.f, 0.f};
#pragma unroll
                for (int k = 0; k < 4; ++k) { const unsigned ww = w[q][k][j]; const f32x2 lo = __builtin_amdgcn_cvt_pk_f32_fp8((int)ww, false), hi = __builtin_amdgcn_cvt_pk_f32_fp8((int)ww, true);
                    t.x += lo[0]; t.y += lo[1]; t.z += hi[0]; t.w += hi[1]; }
                v[q][j] += t * (1.0f / pg8::F8_SY); }
            const float rstd = row_rstd(v[q]);
            if (hout) {
                GAS u32x2* xo = (GAS u32x2*)(X + (size_t)tok * D) + F.lane;
#pragma unroll
                for (int j = 0; j < 4; ++j) xo[64 * j] = (u32x2){pk2(v[q][j].x, v[q][j].y), pk2(v[q][j].z, v[q][j].w)};
                store_row_bf16(hout + (size_t)tok * D, F.lane, v[q], gn, rstd);
            } else {
                GAS f32x4* oo = (GAS f32x4*)(fout + (size_t)tok * D) + F.lane;
#pragma unroll
                for (int j = 0; j < 4; ++j) oo[64 * j] = v[q][j] * rstd * gn[j];
            }
        }
    }
}

struct Args { const float* in[22]; float* out; unsigned char* ws; };
typedef __attribute__((address_space(4))) const Args CArgs;
__device__ __forceinline__ CArgs* kargs() { CArgs* p = (CArgs*)__builtin_amdgcn_kernarg_segment_ptr(); asm volatile("" : "+s"(p)); return p; }
__global__ void __launch_bounds__(NWAVES * 64, 2) mk_fwd(Args args) {
    extern __shared__ __attribute__((aligned(16))) unsigned char lds[];
    Frame F;
    F.lds = (LAS unsigned char*)lds; F.ldsg = lds;
    F.tid = threadIdx.x; F.lane = F.tid & 63; F.wave = __builtin_amdgcn_readfirstlane(F.tid >> 6);
    F.G = gridDim.x; { const int bx = blockIdx.x; F.vcu = (F.G % 8 == 0) ? (bx % 8) * (F.G / 8) + bx / 8 : bx; }
    unsigned* ctl = (unsigned*)(kargs()->ws + WS_CTL);
    for (int u = F.tid; u < (LDS_BYTES - LDSCTL_OFF) / 4; u += NWAVES * 64) ((LAS unsigned*)(F.lds + LDSCTL_OFF))[u] = 0u;
    __syncthreads();
    (void)xcd_barrier_post(ctl + CW_BAR, (volatile LAS unsigned*)(F.lds + MISC_OFF) + 8);

#define IN(i) (kargs()->in[i])
#define WSP(off) (kargs()->ws + (off))
#define x_in IN(0)
#define rel_table IN(1)
#define norm1 IN(2)
#define w_in IN(3)
#define lq1 IN(4)
#define lk1 IN(5)
#define lq2 IN(6)
#define lk2 IN(7)
#define subln_g IN(8)
#define w_pool IN(9)
#define pool_scale IN(10)
#define w_out IN(11)
#define norm2 IN(12)
#define w_router IN(13)
#define b_router IN(14)
#define w_gate IN(15)
#define b_gate IN(16)
#define w_up IN(17)
#define b_up IN(18)
#define w_down IN(19)
#define b_down IN(20)
#define final_norm IN(21)
#define WIN ((bf16_t*)WSP(WS_WIN))
#define WOUT ((bf16_t*)WSP(WS_WOUT))
#define WPOOL ((bf16_t*)WSP(WS_WPOOL))
#define WGU ((bf16_t*)WSP(WS_WGU))
#define WDN ((bf16_t*)WSP(WS_WDN))
#define X ((bf16_t*)WSP(WS_X))
#define VT ((unsigned char*)WSP(WS_X + 64 * MiB))
#define QKVP ((bf16_t*)WSP(RA_QKVP))
#define MIX ((bf16_t*)WSP(RA_MIX))
#define H ((bf16_t*)WSP(RA_H))
#define ACT ((bf16_t*)WSP(WS_RA))
#define H2 ((bf16_t*)WSP(WS_RB))
#define Y ((bf16_t*)WSP(WS_RB))
#define rt_e ((int*)WSP(RT_E))
#define rt_rank ((int*)WSP(RT_RANK))
#define rt_tl ((int*)WSP(RT_TL))
#define rt_gl ((u32x2*)WSP(RT_GL))
    const int gw = F.vcu * NWAVES + F.wave, NGW = F.G * NWAVES;

    {
        LAS float* scr = (LAS float*)(F.lds + F.wave * 16384);
        constexpr int I_IN = (D / 64) * (INW / 32), I_OUT = (D / 64) * (D / 32), I_POOL = 4 * 2 * 4;
        constexpr int PER_L = I_IN + I_OUT + I_POOL;
        for (int it = gw; it < DEPTH * PER_L; it += NGW) {
            const int l = it / PER_L; int r = it % PER_L;
            if (r < I_IN) { const int kb = r / (INW / 32), nb = r % (INW / 32); transpose_item(w_in + (size_t)l * D * INW, D, INW, WIN + (size_t)l * INW * D, 0, scr, 64 * kb, 32 * nb, F.lane); continue; } r -= I_IN;
            if (r < I_OUT) { const int kb = r / (D / 32), nb = r % (D / 32); transpose_item(w_out + (size_t)l * D * D, D, D, WOUT + (size_t)l * D * D, 0, scr, 64 * kb, 32 * nb, F.lane); continue; } r -= I_OUT;
            { const int g = r >> 3, q = r & 7, kb = q >> 2, nb = q & 3; transpose_item(w_pool + (size_t)(l * 4 + g) * 128 * 128, 128, 128, WPOOL + (size_t)(l * 4 + g) * 128 * 128, 0, scr, 64 * kb, 32 * nb, F.lane); }
        }
        convert_experts(F, w_gate, w_up, w_down, WGU, WDN);
        f32x4 gn[4]; load_gain(norm1, F.lane, gn);
        for (int tok = gw; tok < NTOK; tok += NGW) { f32x4 v[4]; load_row(x_in + (size_t)tok * D, F.lane, v); const float rstd = row_rstd(v); store_row_bf16(H + (size_t)tok * D, F.lane, v, gn, rstd); }
    }
    GRID_SYNC();

    for (int l = 0; l < DEPTH; ++l) {
        {
            pg8::Gemm g{H, WIN + (size_t)l * INW * D, D, nullptr}; pg8::DenseOrder S; S.init(NTOK, INW, (int)gridDim.x, (int)blockIdx.x);
            pg8::EpiQkvp E{QKVP};
            pg8::gemm_phase<pg8::EpiQkvp, pg8::DenseOrder>(F.lds, g, S, E);
        }
        GRID_SYNC();
        vt_phase(F, QKVP, VT);
        GRID_SYNC();
        {
            const float lam_init = 0.8f - 0.6f * expf(-0.3f * (float)l);
            const float d1 = wave_sum(lq1[l * 64 + F.lane] * lk1[l * 64 + F.lane]), d2 = wave_sum(lq2[l * 64 + F.lane] * lk2[l * 64 + F.lane]);
            const float lam = expf(d1) - expf(d2) + lam_init;
            const Frame Fa = refresh(F);
            const int xcd = Fa.vcu / (Fa.G / 8), j = Fa.vcu % (Fa.G / 8), per = Fa.G / 8;
            for (int bh2 = 0; bh2 < 2; ++bh2)
                for (int qb = j; qb < SEQ / 128; qb += per) {
                    const int bh = 2 * xcd + bh2;
                    att::attn_unit(bh >> 2, bh & 3, qb, QKVP, VT, MIX, F.ldsg, rel_table, lam, subln_g + l * 128, 1.0f - lam_init);
                }
            pool_phase(F, QKVP, WPOOL + (size_t)l * 4 * 128 * 128, pool_scale + l * 512, MIX);
        }
        GRID_SYNC();
        {
            pg8::Gemm g{MIX, WOUT + (size_t)l * D * D, D, nullptr}; pg8::DenseOrder S; S.init(NTOK, D, (int)gridDim.x, (int)blockIdx.x);
            pg8::EpiResid E{l == 0 ? x_in : nullptr, X, X};
            pg8::gemm_phase<pg8::EpiResid, pg8::DenseOrder>(F.lds, g, S, E);
        }
        GRID_SYNC();
        unsigned* gcnt = (unsigned*)(kargs()->ws + WS_CTL) + CW_ECNT + 64 * NE * l;
        router_phase(F, X, norm2 + l * D, w_router + (size_t)l * D * NE, b_router + l * NE, gcnt, rt_tl, rt_gl, H2);
        GRID_SYNC();
        build_tables(F, gcnt);
        const LAS int* tab = (const LAS int*)(F.lds + TAB_OFF);
        const int ntile = rfl(tab[32]);
        {
            pg8::Gemm g{H2, WGU, D / 2, rt_tl}; pg8::MoeOrder S{tab, 8, 2 * D, 128, ntile * 8, (int)gridDim.x, (int)blockIdx.x, 0};
            pg8::EpiSwiglu E{ACT, b_gate + (size_t)l * NE * D, b_up + (size_t)l * NE * D};
            pg8::gemm_phase<pg8::EpiSwiglu, pg8::MoeOrder, true, true>(F.lds, g, S, E);
        }
        GRID_SYNC();
        {
            pg8::Gemm g{ACT, WDN, D / 2, nullptr}; pg8::MoeOrder S{tab, 4, D, 256, ntile * 4, (int)gridDim.x, (int)blockIdx.x, 1};
            pg8::EpiDown E{Y, b_down + (size_t)l * NE * D, rt_gl};
            pg8::gemm_phase<pg8::EpiDown, pg8::MoeOrder, false, true>(F.lds, g, S, E);
        }
        GRID_SYNC();
        if (l + 1 < DEPTH) {
            convert_experts(F, w_gate + (size_t)(l + 1) * NE * D * D, w_up + (size_t)(l + 1) * NE * D * D, w_down + (size_t)(l + 1) * NE * D * D, WGU, WDN);
            combine_phase(F, X, Y, norm1 + (l + 1) * D, H, nullptr);
            GRID_SYNC();
        } else {
            combine_phase(F, X, Y, final_norm, nullptr, kargs()->out);
        }
    }
}

extern "C" void kernel_launch(void* const* d_in, const int* in_sizes, int n_in, void* d_out, int out_size, void* d_ws, size_t ws_size, hipStream_t stream) {
    static int grid = 0;
    if (grid == 0) {
        if (n_in != 22 || in_sizes[0] != NTOK * D || out_size != NTOK * D || ws_size < WS_END) { fprintf(stderr, "kernel_launch: unexpected shapes (n_in %d, in0 %d, out %d, ws %zu)\n", n_in, n_in > 0 ? in_sizes[0] : -1, out_size, ws_size); grid = -1; return; }
        int dev = 0, cus = 0, per_cu = 0;
        if (hipGetDevice(&dev) != hipSuccess || hipDeviceGetAttribute(&cus, hipDeviceAttributeMultiprocessorCount, dev) != hipSuccess) { grid = -1; return; }
        if (hipFuncSetAttribute((const void*)mk_fwd, hipFuncAttributeMaxDynamicSharedMemorySize, LDS_BYTES) != hipSuccess) { fprintf(stderr, "kernel_launch: hipFuncSetAttribute failed\n"); grid = -1; return; }
        if (hipOccupancyMaxActiveBlocksPerMultiprocessor(&per_cu, (const void*)mk_fwd, NWAVES * 64, LDS_BYTES) != hipSuccess || per_cu < 1) fprintf(stderr, "kernel_launch: occupancy query reports %d\n", per_cu);
        (void)hipGetLastError();
        grid = cus;
        if (grid != 256) { fprintf(stderr, "kernel_launch: built for a 256-CU device (the expert-GEMM gather table holds 17 units per workgroup); found %d CUs, nothing launched\n", cus); grid = -1; return; }
    }
    if (grid < 0) return;
    if (hipMemsetAsync((char*)d_ws + WS_CTL, 0, CTL_ZERO_BYTES, stream) != hipSuccess) return;
    Args a{};
    for (int i = 0; i < 22; ++i) a.in[i] = (const float*)d_in[i];
    a.out = (float*)d_out; a.ws = (unsigned char*)d_ws;
    hipLaunchKernelGGL(mk_fwd, dim3(grid), dim3(NWAVES * 64), LDS_BYTES, stream, a);
}
```

```cpp
#include <hip/hip_runtime.h>
#include <cstdio>
#include <cstdint>

#define LAS __attribute__((address_space(3)))
#define GAS __attribute__((address_space(1)))
typedef unsigned short bf16_t;
typedef short bf16x8 __attribute__((ext_vector_type(8)));
typedef short s16x4 __attribute__((ext_vector_type(4)));
typedef float f32x2 __attribute__((ext_vector_type(2)));
typedef float f32x4 __attribute__((ext_vector_type(4)));
typedef int i32x8 __attribute__((ext_vector_type(8)));
typedef float f32x16 __attribute__((ext_vector_type(16)));
typedef unsigned u32x2 __attribute__((ext_vector_type(2)));
typedef unsigned u32x4 __attribute__((ext_vector_type(4)));
typedef GAS unsigned gu32;

constexpr int D = 1024, BATCH = 4, SEQ = 8192, NTOK = BATCH * SEQ, DEPTH = 2;
constexpr int NH = 4, INW = 2048, NE = 32, TOPK = 4, NASG = NTOK * TOPK;
constexpr float EPS = 1e-5f, LOG2E = 1.4426950408889634f;
constexpr float QSCALE = 0.125f * LOG2E;
constexpr int NWAVES = 8;

constexpr size_t MiB = 1u << 20;
constexpr size_t WS_CTL = 0, CTL_ZERO_BYTES = 1 * MiB;
constexpr size_t WS_WIN = 1 * MiB;
constexpr size_t WS_WOUT = 9 * MiB;
constexpr size_t WS_WPOOL = 13 * MiB;
constexpr size_t WS_ROUTE = 14 * MiB;
constexpr size_t WS_WGU = 18 * MiB;
constexpr size_t WS_WDN = 146 * MiB;
constexpr size_t WS_X = 210 * MiB;
constexpr size_t WS_RA = 338 * MiB;
constexpr size_t WS_RB = 595 * MiB;
constexpr size_t RT_TL = 852 * MiB, RT_GL = 856 * MiB;
constexpr size_t WS_END = 864 * MiB;
constexpr size_t RA_QKVP = WS_RA, RA_MIX = WS_RA + 128 * MiB, RA_H = WS_RA + 192 * MiB;
constexpr size_t RT_E = WS_ROUTE, RT_RANK = WS_ROUTE + 512 * 1024, RT_GATE = WS_ROUTE + 1024 * 1024, RT_POS = WS_ROUTE + 1536 * 1024, RT_GS = WS_ROUTE + 2048 * 1024;
constexpr int CW_BAR = 4096, CW_ECNT = 16384;

constexpr int RING_BYTES = 131072;
constexpr int LDSCTL_OFF = RING_BYTES;
constexpr int MISC_OFF = LDSCTL_OFF + 320;
constexpr int TAB_OFF = LDSCTL_OFF + 1024;
constexpr int GTAB_OFF_ = 133120;
constexpr int LDS_BYTES = 163840;

#define LDS_WAIT() asm volatile("s_waitcnt lgkmcnt(0)" ::: "memory")
#define VM_WAIT() asm volatile("s_waitcnt vmcnt(0)" ::: "memory")
__device__ __forceinline__ unsigned f2bf(float f) { unsigned u = __builtin_bit_cast(unsigned, f); return (u + 0x7fffu + ((u >> 16) & 1u)) >> 16; }
__device__ __forceinline__ unsigned pk2(float lo, float hi) { return f2bf(lo) | (f2bf(hi) << 16); }
__device__ __forceinline__ float bf2f(unsigned short b) { return __builtin_bit_cast(float, (unsigned)b << 16); }
__device__ __forceinline__ unsigned cvt_pk_bf16(float lo, float hi) { unsigned r; asm volatile("v_cvt_pk_bf16_f32 %0, %1, %2" : "=v"(r) : "v"(lo), "v"(hi)); return r; }
__device__ __forceinline__ int rfl(int v) { return __builtin_amdgcn_readfirstlane(v); }
__device__ __forceinline__ unsigned pk4_fp8(float a, float b, float c, float d) { int w; asm("" : "=v"(w)); w = __builtin_amdgcn_cvt_pk_fp8_f32(a, b, w, false); return (unsigned)__builtin_amdgcn_cvt_pk_fp8_f32(c, d, w, true); }

namespace pg8 {
constexpr int BM = 256, BK = 64, HALF = 128, HTB = HALF * BK * 2, STAGE_BYTES = 8 * HTB, NXCD = 8, WGM = 8;
constexpr int GTAB_OFF = 133120, GTAB_UNITS = 17;
constexpr float F8_SH = 8.0f, F8_SG = 64.0f;
constexpr float F8_SY = 4.0f;
constexpr float F8_SA = 4.0f, F8_SW = 64.0f;
__host__ __device__ __forceinline__ int lds_byte(int r, int c) { const int st = (r >> 4) * 2 + (c >> 5), rr = r & 15, cc = c & 31, ob = rr * 64 + cc * 2; return st * 1024 + (ob ^ (((ob >> 9) & 1) << 5)); }
__host__ __device__ __forceinline__ void stage_rc(int b, int& R, int& C) { const int st = b / 1024, sb = b % 1024, swz = sb ^ (((sb >> 9) & 1) << 5); R = (st >> 1) * 16 + swz / 64; C = (st & 1) * 32 + (swz % 64) / 2; }
__host__ __device__ __forceinline__ int perm32(int rho) { const int n = rho >> 4, i = rho & 15; return 8 * (i >> 2) + 4 * n + (i & 3); }

struct Unit { int arow, brow, orow, ocol, valid, e, grow; };
struct Gemm { const bf16_t* A; const bf16_t* Bt; int K; const int* tl; };

struct DenseOrder {
    int nM, nN, nwg, G, c;
    __device__ void init(int M, int N, int G_, int c_) { nM = M / BM; nN = N / BM; nwg = nM * nN; G = G_; c = c_; }
    __device__ bool next(int i, Unit& u) const {
        const long L = (long)i * G + c; if (L >= nwg) return false;
        int wgid = (int)L; { const int q = nwg / NXCD, r = nwg % NXCD, xcd = wgid % NXCD, off = wgid / NXCD; wgid = (xcd < r ? xcd * (q + 1) : r * (q + 1) + (xcd - r) * q) + off; }
        const int nig = WGM * nN, gid = wgid / nig, fm = gid * WGM, gsz = (nM - fm) < WGM ? (nM - fm) : WGM;
        const int pm = fm + ((wgid % nig) % gsz), pn = (wgid % nig) / gsz;
        u.arow = pm * BM; u.brow = pn * BM; u.orow = pm * BM; u.ocol = pn * BM; u.valid = BM; u.e = 0; u.grow = 0; return true;
    }
};
struct MoeOrder {
    const LAS int* tab; int nct, nb, ocw, total, G, c, rev;
    __device__ bool next(int i, Unit& u) const {
        const long L = (long)i * G + c; if (L >= total) return false;
        int wgid = (int)L; { const int q = total / NXCD, r = total % NXCD, xcd = wgid % NXCD, off = wgid / NXCD, len = q + (xcd < r ? 1 : 0); wgid = (xcd < r ? xcd * (q + 1) : r * (q + 1) + (xcd - r) * q) + (rev ? len - 1 - off : off); }
        const int T = wgid / nct, pn = wgid % nct;
        const int ln = (int)__builtin_amdgcn_mbcnt_hi(~0u, __builtin_amdgcn_mbcnt_lo(~0u, 0u)) & 31;
        const int tpv = tab[ln], rbv = tab[33 + ln], cnv = tab[66 + ln];
        const int e = __builtin_popcountll(__builtin_amdgcn_ballot_w64(T >= tpv)) / 2 - 1;
        const int rt = T - __builtin_amdgcn_readlane(tpv, e); const int rb = __builtin_amdgcn_readlane(rbv, e), cn = __builtin_amdgcn_readlane(cnv, e);
        const int left = cn - BM * rt;
        u.e = e; u.arow = rb + BM * rt; u.orow = u.arow; u.valid = left < BM ? left : BM; u.brow = e * nb + pn * BM; u.ocol = pn * ocw; u.grow = e * NTOK + BM * rt; return true;
    }
};

struct EpiQkvp {
    static constexpr bool PERM = true;
    bf16_t* O;
    __device__ __forceinline__ void init(f32x4 (&acc)[2][2][4][2], const Unit&, int, int) const {
#pragma unroll
        for (int a = 0; a < 2; ++a)
#pragma unroll
            for (int b = 0; b < 2; ++b)
#pragma unroll
                for (int m = 0; m < 4; ++m)
#pragma unroll
                    for (int n = 0; n < 2; ++n) acc[a][b][m][n] = (f32x4){0.f, 0.f, 0.f, 0.f};
    }
    __device__ __forceinline__ void operator()(const f32x4 (&acc)[2][2][4][2], const Unit& u, int wr, int wc, int fr, int fq) const {
        const int row0 = u.orow + wr * 64 + fr, col0 = u.ocol + wc * 32 + 8 * fq; const float sc = (u.ocol < 512) ? QSCALE : 1.f;
#pragma unroll
        for (int ai = 0; ai < 2; ++ai)
#pragma unroll
            for (int m = 0; m < 4; ++m) { bf16_t* rowp = O + (size_t)(row0 + ai * HALF + m * 16) * INW + col0;
#pragma unroll
                for (int bj = 0; bj < 2; ++bj) { const f32x4 v0 = acc[ai][bj][m][0] * sc, v1 = acc[ai][bj][m][1] * sc;
                    u32x4 w; w.x = cvt_pk_bf16(v0[0], v0[1]); w.y = cvt_pk_bf16(v0[2], v0[3]); w.z = cvt_pk_bf16(v1[0], v1[1]); w.w = cvt_pk_bf16(v1[2], v1[3]);
                    *(u32x4*)(rowp + bj * HALF) = w; } }
    }
};
struct EpiResid {
    static constexpr bool PERM = true;
    const float* xin32; const bf16_t* xin16; bf16_t* xout;
    __device__ __forceinline__ void init(f32x4 (&acc)[2][2][4][2], const Unit&, int, int) const {
#pragma unroll
        for (int a = 0; a < 2; ++a)
#pragma unroll
            for (int b = 0; b < 2; ++b)
#pragma unroll
                for (int m = 0; m < 4; ++m)
#pragma unroll
                    for (int n = 0; n < 2; ++n) acc[a][b][m][n] = (f32x4){0.f, 0.f, 0.f, 0.f};
    }
    __device__ __forceinline__ void operator()(const f32x4 (&acc)[2][2][4][2], const Unit& u, int wr, int wc, int fr, int fq) const {
        const int row0 = u.orow + wr * 64 + fr, col0 = u.ocol + wc * 32 + 8 * fq;
#define RES_OFF(bt, ml) ((size_t)(row0 + ((bt) >> 1) * HALF + (2 * ((bt) & 1) + (ml)) * 16) * D + col0)
        if (xin32) {
            f32x4 t[2][2][2][2];
#define RES_LD32(bt) do { _Pragma("unroll") for (int ml = 0; ml < 2; ++ml) _Pragma("unroll") for (int bj = 0; bj < 2; ++bj) { const float* p_ = xin32 + RES_OFF(bt, ml) + bj * HALF; \
                t[(bt) & 1][ml][bj][0] = *(const f32x4*)p_; t[(bt) & 1][ml][bj][1] = *(const f32x4*)(p_ + 4); } asm volatile("" ::: "memory"); } while (0)
            RES_LD32(0);
#pragma unroll
            for (int bt = 0; bt < 4; ++bt) {
                if (bt == 0) RES_LD32(1); else if (bt == 1) RES_LD32(2); else if (bt == 2) RES_LD32(3);
                const int ai = bt >> 1;
#pragma unroll
                for (int ml = 0; ml < 2; ++ml) { const int m = 2 * (bt & 1) + ml;
#pragma unroll
                    for (int bj = 0; bj < 2; ++bj) { const f32x4 v0 = t[bt & 1][ml][bj][0] + acc[ai][bj][m][0], v1 = t[bt & 1][ml][bj][1] + acc[ai][bj][m][1];
                        u32x4 w; w.x = cvt_pk_bf16(v0[0], v0[1]); w.y = cvt_pk_bf16(v0[2], v0[3]); w.z = cvt_pk_bf16(v1[0], v1[1]); w.w = cvt_pk_bf16(v1[2], v1[3]);
                        *(u32x4*)(xout + RES_OFF(bt, ml) + bj * HALF) = w; } }
                asm volatile("" ::: "memory");
            }
#undef RES_LD32
        } else {
            u32x4 t[2][2][2];
#define RES_LD16(bt) do { _Pragma("unroll") for (int ml = 0; ml < 2; ++ml) _Pragma("unroll") for (int bj = 0; bj < 2; ++bj) t[(bt) & 1][ml][bj] = *(const u32x4*)(xin16 + RES_OFF(bt, ml) + bj * HALF); \
                asm volatile("" ::: "memory"); } while (0)
            RES_LD16(0);
#pragma unroll
            for (int bt = 0; bt < 4; ++bt) {
                if (bt == 0) RES_LD16(1); else if (bt == 1) RES_LD16(2); else if (bt == 2) RES_LD16(3);
                const int ai = bt >> 1;
#pragma unroll
                for (int ml = 0; ml < 2; ++ml) { const int m = 2 * (bt & 1) + ml;
#pragma unroll
                    for (int bj = 0; bj < 2; ++bj) { const u32x4 b = t[bt & 1][ml][bj]; const f32x4 a0 = acc[ai][bj][m][0], a1 = acc[ai][bj][m][1];
                        u32x4 w; w.x = cvt_pk_bf16(a0[0] + __builtin_bit_cast(float, b.x << 16), a0[1] + __builtin_bit_cast(float, b.x & 0xffff0000u));
                        w.y = cvt_pk_bf16(a0[2] + __builtin_bit_cast(float, b.y << 16), a0[3] + __builtin_bit_cast(float, b.y & 0xffff0000u));
                        w.z = cvt_pk_bf16(a1[0] + __builtin_bit_cast(float, b.z << 16), a1[1] + __builtin_bit_cast(float, b.z & 0xffff0000u));
                        w.w = cvt_pk_bf16(a1[2] + __builtin_bit_cast(float, b.w << 16), a1[3] + __builtin_bit_cast(float, b.w & 0xffff0000u));
                        *(u32x4*)(xout + RES_OFF(bt, ml) + bj * HALF) = w; } }
                asm volatile("" ::: "memory");
            }
#undef RES_LD16
        }
#undef RES_OFF
    }
};
struct EpiSwiglu {
    static constexpr bool PERM = true;
    bf16_t* act; const float* bg; const float* bu;
    __device__ __forceinline__ void init(f32x4 (&acc)[2][2][4][2], const Unit& u, int wc, int fq) const {
        const int col0 = u.ocol + wc * 32 + 8 * fq;
#pragma unroll
        for (int n = 0; n < 2; ++n) { const f32x4 vg = *(const f32x4*)(bg + u.e * D + col0 + 4 * n) * (F8_SH * F8_SG), vu = (*(const f32x4*)(bu + u.e * D + col0 + 4 * n) + 1.0f) * (F8_SH * F8_SG);
#pragma unroll
            for (int ai = 0; ai < 2; ++ai)
#pragma unroll
                for (int m = 0; m < 4; ++m) { acc[ai][0][m][n] = vg; acc[ai][1][m][n] = vu; } }
    }
    __device__ __forceinline__ void operator()(const f32x4 (&acc)[2][2][4][2], const Unit& u, int wr, int wc, int fr, int fq) const {
        const int col0 = u.ocol + wc * 32 + 8 * fq;
#pragma unroll
        for (int ai = 0; ai < 2; ++ai)
#pragma unroll
            for (int m = 0; m < 4; ++m) { const int rl = ai * HALF + wr * 64 + m * 16 + fr;
                float o[8];
#pragma unroll
                for (int n = 0; n < 2; ++n) { f32x4 g, u1;
#pragma unroll
                    for (int i = 0; i < 4; ++i) { float g_, u_;
                        asm("v_min_f32 %0, %1, %2" : "=v"(g_) : "s"(7.0f * (F8_SH * F8_SG)), "v"(acc[ai][0][m][n][i]));
                        asm("v_med3_f32 %0, %1, %2, %3" : "=v"(u_) : "v"(acc[ai][1][m][n][i]), "s"(-6.0f * (F8_SH * F8_SG)), "v"(8.0f * (F8_SH * F8_SG))); g[i] = g_; u1[i] = u_; }
                    f32x4 e = g * (-1.702f * LOG2E / (F8_SH * F8_SG));
#pragma unroll
                    for (int i = 0; i < 4; ++i) e[i] = __builtin_amdgcn_exp2f(e[i]);
                    e = e + 1.0f;
#pragma unroll
                    for (int i = 0; i < 4; ++i) e[i] = __builtin_amdgcn_rcpf(e[i]);
                    const f32x4 r = u1 * (g * e) * (F8_SA / ((F8_SH * F8_SG) * (F8_SH * F8_SG)));
#pragma unroll
                    for (int i = 0; i < 4; ++i) o[4 * n + i] = r[i]; }
                if (rl < u.valid) { u32x2 w; w.x = pk4_fp8(o[0], o[1], o[2], o[3]); w.y = pk4_fp8(o[4], o[5], o[6], o[7]);
                    *(u32x2*)((unsigned char*)act + (size_t)(u.orow + rl) * D + col0) = w; } }
    }
};
struct EpiDown {
    static constexpr bool PERM = true;
    bf16_t* y; const float* bd; const u32x2* gs;
    __device__ __forceinline__ void init(f32x4 (&acc)[2][2][4][2], const Unit& u, int wc, int fq) const {
        const int col0 = u.ocol + wc * 32 + 8 * fq;
#pragma unroll
        for (int bj = 0; bj < 2; ++bj)
#pragma unroll
            for (int n = 0; n < 2; ++n) { const f32x4 bv = *(const f32x4*)(bd + u.e * D + col0 + bj * HALF + 4 * n) * (F8_SA * F8_SW);
#pragma unroll
                for (int ai = 0; ai < 2; ++ai)
#pragma unroll
                    for (int m = 0; m < 4; ++m) acc[ai][bj][m][n] = bv; }
    }
    __device__ __forceinline__ void operator()(const f32x4 (&acc)[2][2][4][2], const Unit& u, int wr, int wc, int fr_, int fq_) const {
        int fr = fr_, fq = fq_; asm volatile("" : "+v"(fr), "+v"(fq));
        const int col0 = u.ocol + wc * 32 + 8 * fq;
        u32x2 gtv[2][4];
#pragma unroll
        for (int ai = 0; ai < 2; ++ai)
#pragma unroll
            for (int m = 0; m < 4; ++m) { const int rl = ai * HALF + wr * 64 + m * 16 + fr; gtv[ai][m] = gs[u.grow + (rl < u.valid ? rl : 0)]; }
#pragma unroll
        for (int ai = 0; ai < 2; ++ai)
#pragma unroll
            for (int m = 0; m < 4; ++m) asm volatile("" : "+v"(gtv[ai][m].x), "+v"(gtv[ai][m].y) :: "memory");
#pragma unroll
        for (int ai = 0; ai < 2; ++ai)
#pragma unroll
            for (int m = 0; m < 4; ++m) { const int rl = ai * HALF + wr * 64 + m * 16 + fr;
                const float gt = __builtin_bit_cast(float, gtv[ai][m].x) * (F8_SY / (F8_SA * F8_SW)); unsigned char* rowp = (unsigned char*)y + (size_t)gtv[ai][m].y * D + col0;
                u32x2 w[2];
#pragma unroll
                for (int bj = 0; bj < 2; ++bj) { const f32x4 v0 = acc[ai][bj][m][0] * gt, v1 = acc[ai][bj][m][1] * gt;
                    w[bj].x = pk4_fp8(v0[0], v0[1], v0[2], v0[3]); w[bj].y = pk4_fp8(v1[0], v1[1], v1[2], v1[3]); }
                if (rl < u.valid) { *(u32x2*)(rowp) = w[0]; *(u32x2*)(rowp + HALF) = w[1]; } }
    }
};

template <class Epi, class Sched, bool GATHER = false, bool FP8 = false>
__device__ __forceinline__ void gemm_phase(LAS unsigned char* lds, const Gemm g, const Sched& S, const Epi& E) {
    int tid_ = threadIdx.x; asm volatile("" : "+v"(tid_));
    const int tid = tid_, wid = __builtin_amdgcn_readfirstlane(tid >> 6), lane = tid & 63, wr = wid >> 2, wc = wid & 3, fr = lane & 15, fq = lane >> 4;
    const int K = g.K, nt = K / BK;
    unsigned voffA[2], voffB[2], cA2[2]; int rA[2];
    unsigned gqc[2][2];
#pragma unroll
    for (int i = 0; i < 2; ++i) { int R, C; stage_rc(tid * 16 + i * 8192, R, C); const int Rb = Epi::PERM ? ((R & ~31) + perm32(R & 31)) : R;
        voffA[i] = (unsigned)(R * K + C) * 2u; voffB[i] = (unsigned)(Rb * K + C) * 2u; rA[i] = R; cA2[i] = (unsigned)C * 2u; }
    const size_t kstep = (size_t)(BK * 2);
    const size_t hstep = (size_t)HALF * K * 2;
    const size_t rstep = (size_t)K * 2;
    const unsigned ldsw = (unsigned)wid * 1024u;
    const int aoff = lds_byte(wr * 64 + fr, fq * 8), boff = lds_byte(wc * 32 + fr, fq * 8);
#define PG8_SA(b, h) (((b) * 2 + (h)) * HTB)
#define PG8_SB(b, h) ((4 + (b) * 2 + (h)) * HTB)
#define PG8_STAGE(bufoff, gbase, voff) do { _Pragma("unroll") for (int _i = 0; _i < 2; ++_i) \
        __builtin_amdgcn_global_load_lds((const unsigned*)((const char*)(gbase) + (voff)[_i]), (LAS unsigned*)(lds + (bufoff) + ldsw + _i * 8192), 16, 0, 0); } while (0)
#define PG8_STAGE_A(bufoff, ptr, h, kt, gq) do { if constexpr (GATHER) { const char* gb_ = (const char*)g.A + (size_t)(kt) * kstep; PG8_STAGE(bufoff, gb_, (gq)[h]); } else { PG8_STAGE(bufoff, (ptr) + (h) * hstep, voffA); } } while (0)
#define PG8_GLOAD(gq, uidx) do { _Pragma("unroll") for (int h_ = 0; h_ < 2; ++h_) _Pragma("unroll") for (int i_ = 0; i_ < 2; ++i_) { \
        const int tok_ = gtab[(uidx) * BM + h_ * HALF + rA[i_]]; (gq)[h_][i_] = (unsigned)tok_ * (unsigned)rstep + cA2[i_]; } } while (0)
#define PG8_LDA(dst, b, h) do { _Pragma("unroll") for (int m = 0; m < 4; ++m) _Pragma("unroll") for (int k = 0; k < 2; ++k) dst[m][k] = *(const LAS bf16x8*)(lds + PG8_SA(b, h) + aoff + m * 2048 + k * 1024); } while (0)
#define PG8_LDB(dst, b, h) do { _Pragma("unroll") for (int n = 0; n < 2; ++n) _Pragma("unroll") for (int k = 0; k < 2; ++k) dst[n][k] = *(const LAS bf16x8*)(lds + PG8_SB(b, h) + boff + n * 2048 + k * 1024); } while (0)
#define PG8_CAT(x0, x1) __builtin_bit_cast(i32x8, __builtin_shufflevector(x0, x1, 0, 1, 2, 3, 4, 5, 6, 7, 8, 9, 10, 11, 12, 13, 14, 15))
#define PG8_MMA(ai, bj, At, Bt) do { if constexpr (!FP8) __builtin_amdgcn_s_setprio(1); if constexpr (FP8) { _Pragma("unroll") for (int m = 0; m < 4; ++m) _Pragma("unroll") for (int n = 0; n < 2; ++n) \
        { const i32x8 a8_ = PG8_CAT(Bt[n][0], Bt[n][1]), b8_ = PG8_CAT(At[m][0], At[m][1]); \
          asm volatile("v_mfma_scale_f32_16x16x128_f8f6f4 %0, %1, %2, %0, %3, %3 op_sel_hi:[0,0,0]" : "+v"(acc[ai][bj][m][n]) : "v"(a8_), "v"(b8_), "v"(f8one)); } } else { \
        _Pragma("unroll") for (int m = 0; m < 4; ++m) _Pragma("unroll") for (int n = 0; n < 2; ++n) _Pragma("unroll") for (int k = 0; k < 2; ++k) \
        acc[ai][bj][m][n] = __builtin_amdgcn_mfma_f32_16x16x32_bf16(Bt[n][k], At[m][k], acc[ai][bj][m][n], 0, 0, 0); } if constexpr (!FP8) __builtin_amdgcn_s_setprio(0); } while (0)
#define PG8_WAIT_V(n) asm volatile("s_waitcnt vmcnt(" #n ")" ::: "memory")
#define PG8_WAIT_L(n) asm volatile("s_waitcnt lgkmcnt(" #n ")" ::: "memory")
#define PG8_BAR __builtin_amdgcn_s_barrier()
#define PG8_SCHED __builtin_amdgcn_sched_barrier(0)
    Unit cur, nxt; int ui = 0;
    if (!S.next(0, cur)) return;
    f32x4 acc[2][2][4][2];
    int f8one = 0x7f7f7f7f; asm volatile("" : "+v"(f8one));
    E.init(acc, cur, wc, fq);
    bf16x8 At[4][2], B0[2][2], B1[2][2];
    const char* cA = (const char*)g.A + (size_t)cur.arow * rstep; const char* cB = (const char*)g.Bt + (size_t)cur.brow * rstep;
    LAS int* gtab = (LAS int*)(lds + GTAB_OFF);
    if constexpr (GATHER) {
        Unit uu;
        for (int i = wid; i < GTAB_UNITS && S.next(i, uu); i += 8) {
            int tk[4];
#pragma unroll
            for (int q = 0; q < 4; ++q) { const int r = lane + 64 * q; tk[q] = g.tl[uu.grow + (r < uu.valid ? r : 0)]; }
#pragma unroll
            for (int q = 0; q < 4; ++q) gtab[i * BM + lane + 64 * q] = tk[q]; }
        asm volatile("s_waitcnt vmcnt(0) lgkmcnt(0)" ::: "memory"); __builtin_amdgcn_s_barrier(); asm volatile("" ::: "memory");
        PG8_GLOAD(gqc, 0);
    }
    PG8_STAGE(PG8_SB(0, 0), cB, voffB); PG8_STAGE(PG8_SB(0, 1), cB + hstep, voffB); PG8_STAGE_A(PG8_SA(0, 0), cA, 0, 0, gqc); PG8_STAGE_A(PG8_SA(0, 1), cA, 1, 0, gqc);
    if (wr == 1) PG8_BAR;
    PG8_WAIT_V(2); PG8_BAR;
    PG8_STAGE(PG8_SB(1, 0), cB + kstep, voffB); PG8_STAGE_A(PG8_SA(1, 0), cA + kstep, 0, 1, gqc); PG8_STAGE(PG8_SB(1, 1), cB + hstep + kstep, voffB);
    PG8_WAIT_V(6); PG8_BAR;
    for (;;) {
        const bool has_next = S.next(ui + 1, nxt);
        const char* nA = has_next ? (const char*)g.A + (size_t)nxt.arow * rstep : cA; const char* nB = has_next ? (const char*)g.Bt + (size_t)nxt.brow * rstep : cB;
        const int un = has_next ? ui + 1 : ui;
#pragma unroll 1
        for (int t = 0; t < nt; t += 2) {
            const bool last = (t == nt - 2);
            const char* a1 = cA + (size_t)(t + 1) * kstep;
            const char* a2 = last ? nA : cA + (size_t)(t + 2) * kstep; const char* b2 = last ? nB : cB + (size_t)(t + 2) * kstep;
            const char* a3 = a2 + kstep; const char* b3 = b2 + kstep;
            const int k2 = last ? 0 : t + 2;
            if constexpr (GATHER) { if (last) {
#pragma unroll
                for (int i_ = 0; i_ < 2; ++i_) gqc[0][i_] = (unsigned)gtab[un * BM + rA[i_]] * (unsigned)rstep + cA2[i_]; } }
            PG8_LDB(B0, 0, 0); PG8_LDB(B1, 0, 1); PG8_SCHED; PG8_LDA(At, 0, 0); PG8_STAGE_A(PG8_SA(1, 1), a1, 1, t + 1, gqc);
            if constexpr (GATHER) { if (last) {
#pragma unroll
                for (int i_ = 0; i_ < 2; ++i_) gqc[1][i_] = (unsigned)gtab[un * BM + HALF + rA[i_]] * (unsigned)rstep + cA2[i_]; } }
            PG8_WAIT_V(8); PG8_WAIT_L(0); PG8_BAR; PG8_MMA(0, 0, At, B0); PG8_MMA(0, 1, At, B1); PG8_BAR; PG8_SCHED;
            PG8_LDA(At, 0, 1); PG8_STAGE(PG8_SB(0, 0), b2, voffB); PG8_STAGE(PG8_SB(0, 1), b2 + hstep, voffB); PG8_STAGE_A(PG8_SA(0, 0), a2, 0, k2, gqc);
            PG8_WAIT_V(8); PG8_WAIT_L(0); PG8_BAR; PG8_MMA(1, 0, At, B0); PG8_MMA(1, 1, At, B1); PG8_BAR; PG8_SCHED;
            PG8_LDB(B0, 1, 0); PG8_LDB(B1, 1, 1); PG8_SCHED; PG8_LDA(At, 1, 0); PG8_STAGE_A(PG8_SA(0, 1), a2, 1, k2, gqc);
            PG8_WAIT_V(8); PG8_WAIT_L(0); PG8_BAR; PG8_MMA(0, 0, At, B0); PG8_MMA(0, 1, At, B1); PG8_BAR; PG8_SCHED;
            PG8_LDA(At, 1, 1); PG8_STAGE(PG8_SB(1, 0), b3, voffB); PG8_STAGE(PG8_SB(1, 1), b3 + hstep, voffB); PG8_STAGE_A(PG8_SA(1, 0), a3, 0, k2 + 1, gqc);
            PG8_WAIT_V(8); PG8_WAIT_L(0); PG8_BAR; PG8_MMA(1, 0, At, B0); PG8_MMA(1, 1, At, B1); PG8_BAR; PG8_SCHED;
        }
        if (wr == 0) PG8_BAR;
        E(acc, cur, wr, wc, fr, fq);
        if (!has_next) break;
        E.init(acc, nxt, wc, fq);
        cur = nxt; cA = nA; cB = nB; ++ui;
        if (wr == 1) PG8_BAR;
    }
    PG8_WAIT_V(0);
    PG8_BAR;
#undef PG8_SA
#undef PG8_CAT
#undef PG8_SB
#undef PG8_STAGE
#undef PG8_STAGE_A
#undef PG8_GLOAD
#undef PG8_LDA
#undef PG8_LDB
#undef PG8_MMA
#undef PG8_WAIT_V
#undef PG8_WAIT_L
#undef PG8_BAR
#undef PG8_SCHED
}
}

#define XB_TMO      128
#define XB_XCNT(j)  (256  + 64 * (j))
#define XB_XSUB(j)  (1280 + 64 * (j))
#define XB_XGEN(j)  (2304 + 64 * (j))
#define XB_TOP      3328
#define XB_TOPGEN   3392
#define XCD_BAR_WORDS 3456
#define XB_SPIN_CAP (1u << 18)
__device__ __forceinline__ unsigned xb_ld(unsigned* p)              { return __hip_atomic_load(p, __ATOMIC_RELAXED, __HIP_MEMORY_SCOPE_AGENT); }
__device__ __forceinline__ unsigned xb_add(unsigned* p, unsigned v) { return __hip_atomic_fetch_add(p, v, __ATOMIC_RELAXED, __HIP_MEMORY_SCOPE_AGENT); }
__device__ __forceinline__ unsigned xb_xcc_id() { return (unsigned)__builtin_amdgcn_s_getreg((3 << 11) | 20) & 0xFu; }
#define XB_SPIN(cond, bar) do { unsigned _sp = 0; while (cond) { __builtin_amdgcn_s_sleep(1); \
    if ((++_sp & 255u) == 0u) { if (xb_ld(&(bar)[XB_TMO])) break; if (_sp > XB_SPIN_CAP) { atomicAdd(&(bar)[XB_TMO], 1u); break; } } } } while (0)
struct XcdBarrier { unsigned* bar; unsigned x; volatile LAS unsigned* st; };
__device__ __forceinline__ XcdBarrier xcd_barrier_post(unsigned* bar, volatile LAS unsigned* st) {
    XcdBarrier b; b.bar = bar; b.x = xb_xcc_id(); b.st = st;
    if (threadIdx.x == 0) (void)xb_add(&bar[XB_XCNT(b.x)], 1u);
    return b;
}
__device__ __forceinline__ void xcd_barrier_complete(unsigned* bar, unsigned x, unsigned& nloc, unsigned& nx) {
    const unsigned G = gridDim.x * gridDim.y * gridDim.z;
    unsigned sum, cnt, mine, sp = 0u;
    for (;;) {
        sum = 0u; cnt = 0u; mine = 0u;
#pragma unroll
        for (unsigned j = 0; j < 16; ++j) { const unsigned c = xb_ld(&bar[XB_XCNT(j)]); sum += c; cnt += (c > 0u) ? 1u : 0u; mine = (j == x) ? c : mine; }
        if (sum == G) break;
        __builtin_amdgcn_s_sleep(1);
        if ((++sp & 255u) == 0u) { if (xb_ld(&bar[XB_TMO])) break; if (sp > XB_SPIN_CAP) { atomicAdd(&bar[XB_TMO], 1u); break; } }
    }
    nloc = mine > 0u ? mine : 1u; nx = cnt > 0u ? cnt : 1u;
}
__device__ __forceinline__ void xcd_barrier(const XcdBarrier& b) {
    asm volatile("s_waitcnt vmcnt(0)" ::: "memory");
    __syncthreads();
    if (threadIdx.x == 0) {
        unsigned* bar = b.bar;
        __builtin_amdgcn_s_waitcnt(0);
        unsigned nloc = b.st[0], nx = b.st[1];
        if (nloc == 0u) { xcd_barrier_complete(bar, b.x, nloc, nx); b.st[0] = nloc; b.st[1] = nx; }
        const unsigned old = xb_add(&bar[XB_XSUB(b.x)], 1u);
        const unsigned gen = old / nloc;
        if (old + 1u == (gen + 1u) * nloc) {
            __builtin_amdgcn_fence(__ATOMIC_RELEASE, "agent");
            asm volatile("s_waitcnt vmcnt(0)" ::: "memory");
            const unsigned og = xb_add(&bar[XB_TOP], 1u);
            const unsigned tg = og / nx;
            if (og + 1u == (tg + 1u) * nx) xb_add(&bar[XB_TOPGEN], 1u);
            else XB_SPIN(xb_ld(&bar[XB_TOPGEN]) == tg, bar);
            __builtin_amdgcn_fence(__ATOMIC_ACQUIRE, "agent");
            xb_add(&bar[XB_XGEN(b.x)], 1u);
            asm volatile("s_waitcnt vmcnt(0)" ::: "memory");
        } else {
            XB_SPIN(xb_ld(&bar[XB_XGEN(b.x)]) == gen, bar);
            __builtin_amdgcn_fence(__ATOMIC_ACQUIRE, "agent");
            asm volatile("s_waitcnt vmcnt(0)" ::: "memory");
        }
    }
    __syncthreads();
}

#define GRID_SYNC() do { XcdBarrier b_; b_.bar = (unsigned*)(kargs()->ws + WS_CTL) + CW_BAR; b_.x = xb_xcc_id(); b_.st = (volatile LAS unsigned*)((LAS unsigned char*)lds + MISC_OFF) + 8; xcd_barrier(b_); } while (0)
struct Frame {
    LAS unsigned char* lds; unsigned char* ldsg;
    int tid, lane, wave, vcu, G;
};
__device__ __forceinline__ int opaque_tid() { int t = threadIdx.x; asm volatile("" : "+v"(t)); return t; }
__device__ __forceinline__ Frame refresh(const Frame& Fi) { Frame F; F.lds = Fi.lds; F.ldsg = Fi.ldsg; F.tid = opaque_tid(); F.lane = F.tid & 63; F.wave = __builtin_amdgcn_readfirstlane(F.tid >> 6);
    int g = (int)gridDim.x, bx = (int)blockIdx.x; asm volatile("" : "+s"(g), "+s"(bx)); F.G = g; F.vcu = (g % 8 == 0) ? (bx % 8) * (g / 8) + bx / 8 : bx; return F; }
__device__ __forceinline__ float wave_sum(float v) {
#pragma unroll
    for (int o = 1; o < 64; o <<= 1) v += __shfl_xor(v, o);
    return v;
}
__device__ __forceinline__ void transpose_item(const float* W, int K, int N, bf16_t* WT, int row_off, LAS float* scr, int k0, int n0, int lane) {
    { const int r8 = lane >> 3, c4 = (lane & 7) * 4;
      f32x4 v[8];
#pragma unroll
      for (int i = 0; i < 8; ++i) v[i] = *(const GAS f32x4*)(W + (size_t)(k0 + 8 * i + r8) * N + n0 + c4);
#pragma unroll
      for (int i = 0; i < 8; ++i) { LAS float* d = scr + (8 * i + r8) * 33 + c4; d[0] = v[i].x; d[1] = v[i].y; d[2] = v[i].z; d[3] = v[i].w; } }
    LDS_WAIT(); asm volatile("" ::: "memory");
    const int c = lane & 7;
#pragma unroll
    for (int j = 0; j < 4; ++j) { const int n = (lane >> 3) + 8 * j; const LAS float* s = scr + (8 * c) * 33 + n;
        u32x4 o; o.x = pk2(s[0 * 33], s[1 * 33]); o.y = pk2(s[2 * 33], s[3 * 33]); o.z = pk2(s[4 * 33], s[5 * 33]); o.w = pk2(s[6 * 33], s[7 * 33]);
        *(GAS u32x4*)(WT + (size_t)(row_off + n0 + n) * K + k0 + 8 * c) = o; }
    LDS_WAIT(); asm volatile("" ::: "memory");
}
__device__ __forceinline__ void transpose_item_f8(const float* W, int K, int N, unsigned char* WT, int row_off, float scale, LAS float* scr, int k0, int n0, int lane) {
    { const int r8 = lane >> 3, c4 = (lane & 7) * 4;
      f32x4 v[8];
#pragma unroll
      for (int i = 0; i < 8; ++i) v[i] = *(const GAS f32x4*)(W + (size_t)(k0 + 8 * i + r8) * N + n0 + c4);
#pragma unroll
      for (int i = 0; i < 8; ++i) { LAS float* d = scr + (8 * i + r8) * 33 + c4; d[0] = v[i].x * scale; d[1] = v[i].y * scale; d[2] = v[i].z * scale; d[3] = v[i].w * scale; } }
    LDS_WAIT(); asm volatile("" ::: "memory");
    const int c = lane & 7;
#pragma unroll
    for (int j = 0; j < 4; ++j) { const int n = (lane >> 3) + 8 * j; const LAS float* s = scr + (8 * c) * 33 + n;
        u32x2 o; o.x = pk4_fp8(s[0 * 33], s[1 * 33], s[2 * 33], s[3 * 33]); o.y = pk4_fp8(s[4 * 33], s[5 * 33], s[6 * 33], s[7 * 33]);
        *(GAS u32x2*)(WT + (size_t)(row_off + n0 + n) * K + k0 + 8 * c) = o; }
    LDS_WAIT(); asm volatile("" ::: "memory");
}
__device__ __forceinline__ void convert_experts(const Frame& Fi, const float* wg, const float* wu, const float* wd, bf16_t* WGU, bf16_t* WDN) {
    Frame F = refresh(Fi);
    LAS float* scr = (LAS float*)(F.lds + F.wave * 16384);
    const int gw = F.vcu * NWAVES + F.wave, NGW = F.G * NWAVES;
    constexpr int IPM = (D / 64) * (D / 32);
    for (int it = gw; it < NE * 3 * IPM; it += NGW) {
        const int e = it / (3 * IPM), r = it % (3 * IPM), which = r / IPM, q = r % IPM, kb = q / (D / 32), nb = q % (D / 32), k0 = 64 * kb, n0 = 32 * nb;
        if (which == 2) transpose_item_f8(wd + (size_t)e * D * D, D, D, (unsigned char*)WDN + (size_t)e * D * D, 0, pg8::F8_SW, scr, k0, n0, F.lane);
        else { const int pn = n0 >> 7, dst0 = pn * 256 + which * 128 + (n0 & 127);
            transpose_item_f8((which ? wu : wg) + (size_t)e * D * D, D, D, (unsigned char*)WGU + (size_t)e * 2 * D * D, dst0 - n0, pg8::F8_SG, scr, k0, n0, F.lane); }
    }
}
__device__ __forceinline__ void load_row(const float* xrow, int lane, f32x4 (&v)[4]) {
    const GAS f32x4* xr = (const GAS f32x4*)xrow + lane;
#pragma unroll
    for (int j = 0; j < 4; ++j) v[j] = xr[64 * j];
}
__device__ __forceinline__ void load_row16(const bf16_t* xrow, int lane, u32x2 (&v)[4]) {
    const GAS u32x2* xr = (const GAS u32x2*)xrow + lane;
#pragma unroll
    for (int j = 0; j < 4; ++j) v[j] = xr[64 * j];
}
__device__ __forceinline__ f32x4 up4(const u32x2 w) { return (f32x4){__builtin_bit_cast(float, w.x << 16), __builtin_bit_cast(float, w.x & 0xffff0000u), __builtin_bit_cast(float, w.y << 16), __builtin_bit_cast(float, w.y & 0xffff0000u)}; }
__device__ __forceinline__ float row_rstd(const f32x4 (&v)[4]) {
    float s = 0.f;
#pragma unroll
    for (int j = 0; j < 4; ++j) s += (v[j].x * v[j].x + v[j].y * v[j].y) + (v[j].z * v[j].z + v[j].w * v[j].w);
    return 1.0f / sqrtf(wave_sum(s) * (1.f / D) + EPS);
}
__device__ __forceinline__ void load_gain(const float* gain, int lane, f32x4 (&g)[4]) {
#pragma unroll
    for (int j = 0; j < 4; ++j) g[j] = *((const GAS f32x4*)gain + lane + 64 * j);
}
__device__ __forceinline__ void store_row_bf16(bf16_t* orow, int lane, const f32x4 (&v)[4], const f32x4 (&g)[4], float rstd) {
    GAS unsigned long long* o8 = (GAS unsigned long long*)orow + lane;
#pragma unroll
    for (int j = 0; j < 4; ++j)
        o8[64 * j] = (unsigned long long)pk2(v[j].x * rstd * g[j].x, v[j].y * rstd * g[j].y) | ((unsigned long long)pk2(v[j].z * rstd * g[j].z, v[j].w * rstd * g[j].w) << 32);
}

__device__ __forceinline__ void vt_phase(const Frame& Fi, const bf16_t* qkvp, unsigned char* vt) {
    Frame F = refresh(Fi);
    const int lane = F.lane;
    LAS unsigned char* scr = F.lds + F.wave * 16384;
    for (int tile = F.vcu * NWAVES + F.wave; tile < BATCH * NH * (SEQ / 64); tile += F.G * NWAVES) {
        const int bh = tile >> 7, t = tile & 127, b = bh >> 2, h = bh & 3;
        const bf16_t* src = qkvp + ((size_t)b * SEQ + 64 * t) * INW + 1024 + h * 128;
        unsigned char* dst = vt + (size_t)tile * 8192;
#pragma unroll 1
        for (int part = 0; part < 2; ++part) {
            u32x4 v[8];
#pragma unroll
            for (int i = 0; i < 8; ++i) { const int pc = lane + 64 * i; v[i] = *(const u32x4*)(src + (size_t)(32 * part + (pc >> 4)) * INW + (pc & 15) * 8); }
#pragma unroll
            for (int i = 0; i < 8; ++i) { const int pc = lane + 64 * i; *(LAS u32x4*)(scr + (pc >> 4) * 272 + (pc & 15) * 16) = v[i]; }
            LDS_WAIT(); asm volatile("" ::: "memory");
#pragma unroll
            for (int dd = 0; dd < 2; ++dd) { const int dv = lane + 64 * dd; unsigned wd[8];
#pragma unroll
                for (int g = 0; g < 8; ++g) { float f[4];
#pragma unroll
                    for (int j = 0; j < 4; ++j) f[j] = __builtin_bit_cast(float, (unsigned)(*(const LAS unsigned short*)(scr + (4 * g + j) * 272 + dv * 2)) << 16) * 16.0f;
                    wd[g] = pk4_fp8(f[0], f[1], f[2], f[3]); }
                const int sw = (dv >> 2) & 3;
                *(u32x4*)(dst + dv * 64 + (((0 + part) ^ sw) << 4)) = (u32x4){wd[0], wd[2], wd[4], wd[6]};
                *(u32x4*)(dst + dv * 64 + (((2 + part) ^ sw) << 4)) = (u32x4){wd[1], wd[3], wd[5], wd[7]}; }
            LDS_WAIT(); asm volatile("" ::: "memory");
        }
    }
}

namespace att {
constexpr int PITCH = INW, NT = SEQ / 64, SLOTB = 32768, VOFF = 16384;
constexpr int L_V = 65536, L_ONES = 98304, L_LUT = 100352, L_WSF = 102400, L_STG = 65536;
constexpr float THR = 8.0f;
__device__ __forceinline__ int crow(int r, int hi) { return (r & 3) + 8 * (r >> 2) + 4 * hi; }
__device__ __forceinline__ void glds16(const void* sbase, unsigned voff, unsigned lds_dst) { unsigned keep;
    asm volatile("s_mov_b32 %0, m0\n\ts_mov_b32 m0, %3\n\ts_nop 0\n\tglobal_load_lds_dwordx4 %1, %2\n\ts_mov_b32 m0, %0" : "=&s"(keep) : "v"(voff), "s"(sbase), "s"(lds_dst) : "memory"); }
#define ATT_WAIT_BAR() asm volatile("s_waitcnt vmcnt(0) lgkmcnt(0)\n\ts_barrier" ::: "memory")
#define ATT_BAR() asm volatile("s_waitcnt lgkmcnt(0)\n\ts_barrier" ::: "memory")
__device__ __forceinline__ s16x4 vtr(const LAS char* p) { return __builtin_bit_cast(s16x4, __builtin_amdgcn_ds_read_tr16_b64_v4i16((LAS s16x4*)p)); }
__device__ __forceinline__ int rel_bucket(int rel) {
    const int ret = rel > 0 ? 16 : 0; const int n = rel < 0 ? -rel : rel;
    if (n < 8) return ret + n;
    int j = 0; while (j < 7 && 64 * (2 << j) <= n * n) ++j;
    return ret + 8 + j;
}
__device__ __forceinline__ void qkt(f32x16& p0, f32x16& p1, const LAS char* kb, const bf16x8 (&qr)[4], const f32x16& cin) {
#pragma unroll
    for (int d0 = 0; d0 < 4; ++d0) {
        const bf16x8 b0 = *(const LAS bf16x8*)(kb + d0 * 2048);
        const bf16x8 b1 = *(const LAS bf16x8*)(kb + d0 * 2048 + 512);
        if (d0 == 0) { p0 = __builtin_amdgcn_mfma_f32_32x32x16_bf16(b0, qr[0], cin, 0, 0, 0); p1 = __builtin_amdgcn_mfma_f32_32x32x16_bf16(b1, qr[0], cin, 0, 0, 0); }
        else { p0 = __builtin_amdgcn_mfma_f32_32x32x16_bf16(b0, qr[d0], p0, 0, 0, 0); p1 = __builtin_amdgcn_mfma_f32_32x32x16_bf16(b1, qr[d0], p1, 0, 0, 0); }
    }
}
#define MX3(a, b, c) __builtin_fmaxf(__builtin_fmaxf((a), (b)), (c))
__device__ __forceinline__ float rowmax(const f32x16& p0, const f32x16& p1) {
    float a = MX3(p0[0], p0[1], p1[0]), b = MX3(p0[2], p0[3], p1[1]); a = MX3(a, p1[2], p1[3]);
#pragma unroll
    for (int r = 4; r < 16; r += 4) { a = MX3(a, p0[r], p0[r + 1]); b = MX3(b, p0[r + 2], p0[r + 3]); a = MX3(a, p1[r], p1[r + 1]); b = MX3(b, p1[r + 2], p1[r + 3]); }
    float rm = __builtin_fmaxf(a, b);
    auto rr = __builtin_amdgcn_permlane32_swap(__float_as_uint(rm), __float_as_uint(rm), false, false);
    return __builtin_fmaxf(__uint_as_float(rr[0]), __uint_as_float(rr[1]));
}
__device__ __forceinline__ void attn_unit(int b, int h, int qb, const bf16_t* __restrict__ qkvp, const unsigned char* __restrict__ vt, bf16_t* mix, unsigned char* shm, const float* rel_table, float lam, const float* subg, float oscale) {
    int tid_ = threadIdx.x; asm volatile("" : "+v"(tid_));
    const int tid = tid_, lane = tid & 63, r32 = lane & 31, hi = lane >> 5;
    const int wid = __builtin_amdgcn_readfirstlane(tid >> 6), wq = wid >> 1, mp = wid & 1;
    const long rowbase = (long)b * SEQ; const int q0 = qb * 128;
    const unsigned lds0 = (unsigned)(uintptr_t)shm;
    LAS unsigned char* shm3 = (LAS unsigned char*)shm;
    LAS float* lut = (LAS float*)(shm3 + L_LUT);
    LAS float* wsf = (LAS float*)(shm3 + L_WSF) + wid * 64;
    const float lutv = rel_table[rel_bucket(min(tid, 446) - 223) * NH + h];
    const float cL = rel_table[15 * NH + h] * LOG2E, cR = rel_table[31 * NH + h] * LOG2E;
    const bf16_t* Qw = qkvp + (rowbase + q0 + wq * 32 + r32) * PITCH + h * 128 + mp * 64;
    bf16x8 qr[4];
#pragma unroll
    for (int d0 = 0; d0 < 4; ++d0) qr[d0] = *(const bf16x8*)(Qw + d0 * 16 + hi * 8);
    const bf16_t* ksrc = qkvp + rowbase * PITCH + 512 + h * 128 + wid * 8;
    const unsigned char* vsrc = vt + (size_t)((b * NH + h) * NT) * 8192 + wid * 1024;
    const unsigned kvo = (unsigned)lane * PITCH * 2u, vvo = (unsigned)lane * 16u;
    const unsigned dst0 = lds0 + wid * 1024;
#define ATT_ISSUE_K(t) do { const bf16_t* ks_ = ksrc + (long)(t) * 64 * PITCH; const unsigned d_ = (unsigned)__builtin_amdgcn_readfirstlane(dst0 + ((t) & 3) * 16384); glds16(ks_, kvo, d_); glds16(ks_ + 64, kvo, d_ + 8192); } while (0)
#define ATT_ISSUE_K1(t, pc) do { const bf16_t* ks_ = ksrc + (long)(t) * 64 * PITCH + (pc) * 64; const unsigned d_ = (unsigned)__builtin_amdgcn_readfirstlane(dst0 + ((t) & 3) * 16384 + (pc) * 8192); glds16(ks_, kvo, d_); } while (0)
#define ATT_ISSUE_V1(t, pc) do { if ((pc) == 0) { const unsigned char* vs_ = vsrc + (size_t)(t) * 8192; const unsigned d_ = (unsigned)__builtin_amdgcn_readfirstlane(dst0 + L_V + ((t) & 3) * 8192); glds16(vs_, vvo, d_); } } while (0)
#define ATT_ISSUE_V(t) ATT_ISSUE_V1(t, 0)
    const LAS char* kp0 = (const LAS char*)shm3 + mp * 8192 + hi * 1024 + r32 * 16;
    const LAS char* vp0 = (const LAS char*)shm3 + L_V + r32 * 64 + (((2 * hi) ^ ((r32 >> 2) & 3)) << 4);
    const LAS char* vq0 = (const LAS char*)shm3 + L_V + r32 * 64 + (((2 * hi + 1) ^ ((r32 >> 2) & 3)) << 4);
    const LAS char* vo0 = (const LAS char*)shm3 + L_ONES + r32 * 64;
    f32x16 o[5];
#pragma unroll
    for (int d = 0; d < 5; ++d)
#pragma unroll
        for (int r = 0; r < 16; ++r) o[d][r] = 0.f;
    float m_run = 0.f;
    const int qlo = q0 + wq * 32, qq = qlo + r32;
    f32x16 negm;
    float ct_cur;
    bool resc;
#define ATT_CLASS(t) ((64 * (t) + 63 - qlo <= -128) ? 0 : ((64 * (t) - (qlo + 31) >= 128) ? 2 : 1))
#define ATT_LUTADD(S0, S1, t) do { asm volatile("" ::: "memory");     \
        const LAS float* lb_ = lut + (64 * (t) + 4 * hi - qq + 223);          \
        _Pragma("unroll") for (int r = 0; r < 16; ++r) { S0[r] += lb_[(r & 3) + 8 * (r >> 2)]; S1[r] += lb_[(r & 3) + 8 * (r >> 2) + 32]; } } while (0)
#define SBAR() __builtin_amdgcn_sched_barrier(0)
#define ATT_VRD8(d) do { if ((d) == 4) { vf8[0][0] = *(const LAS u32x4*)(vo0); vf8[0][1] = *(const LAS u32x4*)(vo0 + 16); } else { vf8[(d) & 1][0] = *(const LAS u32x4*)(vp_ + (d) * 2048); vf8[(d) & 1][1] = *(const LAS u32x4*)(vq_ + (d) * 2048); } } while (0)
#define ATT_CAT8(x0, x1) __builtin_bit_cast(i32x8, __builtin_shufflevector(x0, x1, 0, 1, 2, 3, 4, 5, 6, 7))
#define ATT_PV8(d) do { const i32x8 a8_ = ATT_CAT8(p8a, p8b), b8_ = ATT_CAT8(vf8[(d) & 1][0], vf8[(d) & 1][1]); \
        asm volatile("v_mfma_scale_f32_32x32x64_f8f6f4 %0, %1, %2, %0, %3, %3 op_sel_hi:[0,0,0]" : "+v"(o[d]) : "v"(a8_), "v"(b8_), "v"(f8one)); } while (0)
#define ATT_KRD(j) do { kfr[(j) % 3] = *(const LAS bf16x8*)(kq_ + ((j) >> 1) * 2048 + ((j) & 1) * 512); } while (0)
#define ATT_STEP(C0, C1, N0, N1, t, HASQK) do { \
        const int cls_ = ATT_CLASS((t) + 1); const float ctn_ = cls_ == 0 ? cL : (cls_ == 2 ? cR : 0.f); \
        if (HASQK) { if (ctn_ != ct_cur) { asm volatile("" ::: "memory"); const float cm_ = ctn_ - m_run;     \
            _Pragma("unroll") for (int r = 0; r < 16; ++r) negm[r] = cm_; \
            ct_cur = ctn_; } } \
        const LAS char* kq_ = kp0 + (((t) + 1) & 3) * 16384; const LAS char* vp_ = vp0 + (((t) - 1) & 3) * 8192; const LAS char* vq_ = vq0 + (((t) - 1) & 3) * 8192; \
        float ra_ = 0.f, rb_ = 0.f; \
        ATT_VRD8(0); ATT_VRD8(1); if (HASQK) { ATT_KRD(0); ATT_KRD(1); } \
        __builtin_amdgcn_s_setprio(1); SBAR(); \
        ATT_PV8(0); ATT_VRD8(2); C0[0] = __builtin_amdgcn_exp2f(C0[0]); C0[1] = __builtin_amdgcn_exp2f(C0[1]); asm volatile("" : "+v"(C0[0])); asm volatile("" : "+v"(C0[1])); if ((t) + 3 < NT) ATT_ISSUE_K1((t) + 3, 0); SBAR(); \
        if (HASQK) { N0 = __builtin_amdgcn_mfma_f32_32x32x16_bf16(kfr[0], qr[0], negm, 0, 0, 0); ATT_KRD(2); } SBAR(); \
        ATT_PV8(1); ATT_VRD8(3); C0[2] = __builtin_amdgcn_exp2f(C0[2]); C0[3] = __builtin_amdgcn_exp2f(C0[3]); asm volatile("" : "+v"(C0[2])); asm volatile("" : "+v"(C0[3])); if ((t) + 1 < NT) ATT_ISSUE_V1((t) + 1, 0); SBAR(); \
        if (HASQK) { N1 = __builtin_amdgcn_mfma_f32_32x32x16_bf16(kfr[1], qr[0], negm, 0, 0, 0); ATT_KRD(3); } SBAR(); \
        ATT_PV8(2); ATT_VRD8(4); C0[4] = __builtin_amdgcn_exp2f(C0[4]); C0[5] = __builtin_amdgcn_exp2f(C0[5]); asm volatile("" : "+v"(C0[4])); asm volatile("" : "+v"(C0[5])); if ((t) + 3 < NT) ATT_ISSUE_K1((t) + 3, 1); SBAR(); \
        if (HASQK) { N0 = __builtin_amdgcn_mfma_f32_32x32x16_bf16(kfr[2], qr[1], N0, 0, 0, 0); ATT_KRD(4); } SBAR(); \
        ATT_PV8(3); ATT_PV8(4); C0[6] = __builtin_amdgcn_exp2f(C0[6]); C0[7] = __builtin_amdgcn_exp2f(C0[7]); asm volatile("" : "+v"(C0[6])); asm volatile("" : "+v"(C0[7]));  SBAR(); \
        if (HASQK) { N1 = __builtin_amdgcn_mfma_f32_32x32x16_bf16(kfr[0], qr[1], N1, 0, 0, 0); ATT_KRD(5); } SBAR(); \
        C0[8] = __builtin_amdgcn_exp2f(C0[8]); C0[9] = __builtin_amdgcn_exp2f(C0[9]); asm volatile("" : "+v"(C0[8])); asm volatile("" : "+v"(C0[9])); p8a[0] = (unsigned)__builtin_amdgcn_cvt_pk_fp8_f32(C0[0], C0[1], (int)p8a[0], false); SBAR(); \
        if (HASQK) { N0 = __builtin_amdgcn_mfma_f32_32x32x16_bf16(kfr[1], qr[2], N0, 0, 0, 0); ATT_KRD(6); } SBAR(); \
        C0[10] = __builtin_amdgcn_exp2f(C0[10]); C0[11] = __builtin_amdgcn_exp2f(C0[11]); asm volatile("" : "+v"(C0[10])); asm volatile("" : "+v"(C0[11])); p8a[0] = (unsigned)__builtin_amdgcn_cvt_pk_fp8_f32(C0[2], C0[3], (int)p8a[0], true); SBAR(); \
        if (HASQK) { N1 = __builtin_amdgcn_mfma_f32_32x32x16_bf16(kfr[2], qr[2], N1, 0, 0, 0); ATT_KRD(7); } SBAR(); \
        C0[12] = __builtin_amdgcn_exp2f(C0[12]); C0[13] = __builtin_amdgcn_exp2f(C0[13]); asm volatile("" : "+v"(C0[12])); asm volatile("" : "+v"(C0[13])); p8a[1] = (unsigned)__builtin_amdgcn_cvt_pk_fp8_f32(C0[4], C0[5], (int)p8a[1], false); SBAR(); \
        if (HASQK) { N0 = __builtin_amdgcn_mfma_f32_32x32x16_bf16(kfr[0], qr[3], N0, 0, 0, 0); } SBAR(); \
        C0[14] = __builtin_amdgcn_exp2f(C0[14]); C0[15] = __builtin_amdgcn_exp2f(C0[15]); asm volatile("" : "+v"(C0[14])); asm volatile("" : "+v"(C0[15])); p8a[1] = (unsigned)__builtin_amdgcn_cvt_pk_fp8_f32(C0[6], C0[7], (int)p8a[1], true); SBAR(); \
        if (HASQK) { N1 = __builtin_amdgcn_mfma_f32_32x32x16_bf16(kfr[1], qr[3], N1, 0, 0, 0); } __builtin_amdgcn_s_setprio(0); SBAR(); \
        if (HASQK) { if (cls_ == 1) ATT_LUTADD(N0, N1, (t) + 1); } SBAR(); \
        C1[0] = __builtin_amdgcn_exp2f(C1[0]); C1[1] = __builtin_amdgcn_exp2f(C1[1]); asm volatile("" : "+v"(C1[0])); asm volatile("" : "+v"(C1[1])); p8a[2] = (unsigned)__builtin_amdgcn_cvt_pk_fp8_f32(C0[8], C0[9], (int)p8a[2], false); if (HASQK) { ra_ = MX3(N0[0], N0[1], N1[0]); } if (HASQK) { rb_ = MX3(N0[2], N0[3], N1[1]); } if (HASQK) { asm volatile("" : "+v"(ra_), "+v"(rb_)); } SBAR(); \
        C1[2] = __builtin_amdgcn_exp2f(C1[2]); C1[3] = __builtin_amdgcn_exp2f(C1[3]); asm volatile("" : "+v"(C1[2])); asm volatile("" : "+v"(C1[3])); p8a[2] = (unsigned)__builtin_amdgcn_cvt_pk_fp8_f32(C0[10], C0[11], (int)p8a[2], true); if (HASQK) { ra_ = MX3(ra_, N1[2], N1[3]); } if (HASQK) { ra_ = MX3(ra_, N0[4], N0[5]); } if (HASQK) { asm volatile("" : "+v"(ra_), "+v"(rb_)); } SBAR(); \
        C1[4] = __builtin_amdgcn_exp2f(C1[4]); C1[5] = __builtin_amdgcn_exp2f(C1[5]); asm volatile("" : "+v"(C1[4])); asm volatile("" : "+v"(C1[5])); p8a[3] = (unsigned)__builtin_amdgcn_cvt_pk_fp8_f32(C0[12], C0[13], (int)p8a[3], false); if (HASQK) { rb_ = MX3(rb_, N0[6], N0[7]); } if (HASQK) { ra_ = MX3(ra_, N1[4], N1[5]); } if (HASQK) { asm volatile("" : "+v"(ra_), "+v"(rb_)); } SBAR(); \
        C1[6] = __builtin_amdgcn_exp2f(C1[6]); C1[7] = __builtin_amdgcn_exp2f(C1[7]); asm volatile("" : "+v"(C1[6])); asm volatile("" : "+v"(C1[7])); p8a[3] = (unsigned)__builtin_amdgcn_cvt_pk_fp8_f32(C0[14], C0[15], (int)p8a[3], true); if (HASQK) { rb_ = MX3(rb_, N1[6], N1[7]); } if (HASQK) { ra_ = MX3(ra_, N0[8], N0[9]); } if (HASQK) { asm volatile("" : "+v"(ra_), "+v"(rb_)); } SBAR(); \
        C1[8] = __builtin_amdgcn_exp2f(C1[8]); C1[9] = __builtin_amdgcn_exp2f(C1[9]); asm volatile("" : "+v"(C1[8])); asm volatile("" : "+v"(C1[9])); p8b[0] = (unsigned)__builtin_amdgcn_cvt_pk_fp8_f32(C1[0], C1[1], (int)p8b[0], false); if (HASQK) { rb_ = MX3(rb_, N0[10], N0[11]); } if (HASQK) { ra_ = MX3(ra_, N1[8], N1[9]); } if (HASQK) { asm volatile("" : "+v"(ra_), "+v"(rb_)); } SBAR(); \
        C1[10] = __builtin_amdgcn_exp2f(C1[10]); C1[11] = __builtin_amdgcn_exp2f(C1[11]); asm volatile("" : "+v"(C1[10])); asm volatile("" : "+v"(C1[11])); p8b[0] = (unsigned)__builtin_amdgcn_cvt_pk_fp8_f32(C1[2], C1[3], (int)p8b[0], true); if (HASQK) { rb_ = MX3(rb_, N1[10], N1[11]); } if (HASQK) { ra_ = MX3(ra_, N0[12], N0[13]); } if (HASQK) { asm volatile("" : "+v"(ra_), "+v"(rb_)); } SBAR(); \
        C1[12] = __builtin_amdgcn_exp2f(C1[12]); C1[13] = __builtin_amdgcn_exp2f(C1[13]); asm volatile("" : "+v"(C1[12])); asm volatile("" : "+v"(C1[13])); p8b[1] = (unsigned)__builtin_amdgcn_cvt_pk_fp8_f32(C1[4], C1[5], (int)p8b[1], false); if (HASQK) { rb_ = MX3(rb_, N0[14], N0[15]); } if (HASQK) { ra_ = MX3(ra_, N1[12], N1[13]); } if (HASQK) { asm volatile("" : "+v"(ra_), "+v"(rb_)); } SBAR(); \
        C1[14] = __builtin_amdgcn_exp2f(C1[14]); C1[15] = __builtin_amdgcn_exp2f(C1[15]); asm volatile("" : "+v"(C1[14])); asm volatile("" : "+v"(C1[15])); p8b[1] = (unsigned)__builtin_amdgcn_cvt_pk_fp8_f32(C1[6], C1[7], (int)p8b[1], true); if (HASQK) { rb_ = MX3(rb_, N1[14], N1[15]); } if (HASQK) { asm volatile("" : "+v"(ra_), "+v"(rb_)); } SBAR(); \
        p8b[2] = (unsigned)__builtin_amdgcn_cvt_pk_fp8_f32(C1[8], C1[9], (int)p8b[2], false); p8b[2] = (unsigned)__builtin_amdgcn_cvt_pk_fp8_f32(C1[10], C1[11], (int)p8b[2], true); p8b[3] = (unsigned)__builtin_amdgcn_cvt_pk_fp8_f32(C1[12], C1[13], (int)p8b[3], false); p8b[3] = (unsigned)__builtin_amdgcn_cvt_pk_fp8_f32(C1[14], C1[15], (int)p8b[3], true); \
        if (resc) { LDS_WAIT(); \
            _Pragma("unroll") for (int r = 0; r < 16; ++r) { const float fr_ = wsf[crow(r, hi)]; \
                _Pragma("unroll") for (int d = 0; d < 5; ++d) o[d][r] *= fr_; } } \
        resc = false; \
        if (HASQK) { float rm_ = __builtin_fmaxf(ra_, rb_); \
            { auto rr_ = __builtin_amdgcn_permlane32_swap(__float_as_uint(rm_), __float_as_uint(rm_), false, false); rm_ = __builtin_fmaxf(__uint_as_float(rr_[0]), __uint_as_float(rr_[1])); } \
            if (__any(rm_ > THR)) { const float dl_ = __builtin_fmaxf(rm_, 0.f); m_run += dl_; \
                _Pragma("unroll") for (int r = 0; r < 16; ++r) { N0[r] -= dl_; N1[r] -= dl_; negm[r] -= dl_; } \
                const float f_ = __builtin_amdgcn_exp2f(-dl_); if (hi == 0) wsf[r32] = f_; resc = true; } } \
    } while (0)
    int f8one = 0x7f7f7f7f; asm volatile("" : "+v"(f8one));
    f32x16 sA0, sA1, sB0, sB1; u32x4 p8a, p8b, vf8[2][2]; bf16x8 kfr[3];
    ATT_ISSUE_K(0); ATT_ISSUE_K(1);
    if (tid < 447) lut[tid] = lutv * LOG2E;
    if (tid < 128) { unsigned fill = (tid < 4) ? 0x38383838u : 0u; asm volatile("" : "+v"(fill));
        *(LAS u32x4*)(shm3 + L_ONES + tid * 16) = (u32x4){fill, fill, fill, fill}; }
    ATT_WAIT_BAR();
    ATT_ISSUE_K(2); ATT_ISSUE_K(3); ATT_ISSUE_V(0); ATT_ISSUE_V(1);
    {
        const int cls = ATT_CLASS(0); ct_cur = cls == 0 ? cL : (cls == 2 ? cR : 0.f);
#pragma unroll
        for (int r = 0; r < 16; ++r) negm[r] = ct_cur;
        qkt(sA0, sA1, kp0, qr, negm);
        if (cls == 1) ATT_LUTADD(sA0, sA1, 0);
        const float rm = rowmax(sA0, sA1); m_run = rm;
#pragma unroll
        for (int r = 0; r < 16; ++r) { sA0[r] = __builtin_amdgcn_exp2f(sA0[r] - rm); sA1[r] = __builtin_amdgcn_exp2f(sA1[r] - rm); }
#pragma unroll
        for (int i = 0; i < 4; ++i) { p8a[i] = pk4_fp8(sA0[4 * i], sA0[4 * i + 1], sA0[4 * i + 2], sA0[4 * i + 3]); p8b[i] = pk4_fp8(sA1[4 * i], sA1[4 * i + 1], sA1[4 * i + 2], sA1[4 * i + 3]); }
        const int cls1 = ATT_CLASS(1); ct_cur = cls1 == 0 ? cL : (cls1 == 2 ? cR : 0.f);
        { const float cm = ct_cur - m_run;
#pragma unroll
          for (int r = 0; r < 16; ++r) negm[r] = cm; }
        qkt(sB0, sB1, kp0 + 16384, qr, negm);
        if (cls1 == 1) ATT_LUTADD(sB0, sB1, 1);
        const float rm1 = rowmax(sB0, sB1); resc = false;
        if (__any(rm1 > THR)) { const float dl = __builtin_fmaxf(rm1, 0.f); m_run += dl;
#pragma unroll
            for (int r = 0; r < 16; ++r) { sB0[r] -= dl; sB1[r] -= dl; negm[r] -= dl; }
            const float f = __builtin_amdgcn_exp2f(-dl); if (hi == 0) wsf[r32] = f; resc = true; }
    }
    {
        int t = 1;
        for (; t + 2 < NT; t += 2) { ATT_WAIT_BAR(); ATT_STEP(sB0, sB1, sA0, sA1, t, true); ATT_STEP(sA0, sA1, sB0, sB1, t + 1, true); }
        ATT_WAIT_BAR(); ATT_STEP(sB0, sB1, sA0, sA1, t, false);
    }
    ATT_WAIT_BAR();
    {
        const LAS char* vp_ = vp0 + ((NT - 1) & 3) * 8192; const LAS char* vq_ = vq0 + ((NT - 1) & 3) * 8192;
        ATT_VRD8(0); ATT_VRD8(1);
        SBAR();
        ATT_PV8(0); ATT_VRD8(2); SBAR();
        ATT_PV8(1); ATT_VRD8(3); SBAR();
        ATT_PV8(2); ATT_VRD8(4); SBAR();
        ATT_PV8(3); SBAR();
        ATT_PV8(4); SBAR();
        asm volatile("s_nop 15\n\ts_nop 15\n\ts_nop 15\n\ts_nop 15" ::: "memory");
    }
    if (resc) { LDS_WAIT();
#pragma unroll
        for (int r = 0; r < 16; ++r) { const float fr_ = wsf[crow(r, hi)];
#pragma unroll
            for (int d = 0; d < 5; ++d) o[d][r] *= fr_; } }
#undef ATT_STEP
#undef ATT_KRD
#undef ATT_VRD8
#undef ATT_PV8
#undef ATT_CAT8
#undef SBAR
#undef ATT_LUTADD
#undef ATT_CLASS
#undef ATT_ISSUE_K
#undef ATT_ISSUE_K1
#undef ATT_ISSUE_V1
#undef ATT_ISSUE_V
    if (r32 == 0) {
#pragma unroll
        for (int r = 0; r < 16; ++r) wsf[32 + crow(r, hi)] = (1.0f / 16.0f) / o[4][r]; }
    LDS_WAIT();
#pragma unroll
    for (int r = 0; r < 16; ++r) { const float rl_ = wsf[32 + crow(r, hi)];
#pragma unroll
        for (int d = 0; d < 4; ++d) o[d][r] *= rl_; }
    ATT_BAR();
    LAS float* X = (LAS float*)shm3 + wq * 4096;
    if (mp == 1) {
#pragma unroll
        for (int d = 0; d < 4; ++d)
#pragma unroll
            for (int r = 0; r < 16; ++r) X[(d * 16 + r) * 64 + lane] = o[d][r];
    }
    ATT_BAR();
    if (mp == 0) {
#pragma unroll
        for (int d = 0; d < 4; ++d)
#pragma unroll
            for (int r = 0; r < 16; ++r) o[d][r] -= lam * X[(d * 16 + r) * 64 + lane];
        float gsc[4];
#pragma unroll
        for (int d = 0; d < 4; ++d) gsc[d] = subg[32 * d + r32] * oscale;
        LAS bf16_t* stg = (LAS bf16_t*)(shm3 + L_STG) + wq * 4096;
#pragma unroll
        for (int r = 0; r < 16; ++r) {
            float ss = (o[0][r] * o[0][r] + o[1][r] * o[1][r]) + (o[2][r] * o[2][r] + o[3][r] * o[3][r]);
#pragma unroll
            for (int x = 1; x < 32; x <<= 1) ss += __shfl_xor(ss, x);
            const float rstd = 1.0f / sqrtf(ss * (1.f / 128.f) + EPS);
#pragma unroll
            for (int d = 0; d < 4; ++d) stg[crow(r, hi) * 128 + 32 * d + r32] = (bf16_t)f2bf(o[d][r] * rstd * gsc[d]);
        }
        LDS_WAIT();
        bf16_t* Ow = mix + (rowbase + q0 + wq * 32) * D + h * 128;
#pragma unroll
        for (int i = 0; i < 8; ++i) { const int row = 4 * i + (lane >> 4), ch = lane & 15; const u32x4 v = *(const LAS u32x4*)(stg + row * 128 + ch * 8); *(u32x4*)(Ow + (long)row * D + ch * 8) = v; }
    }
    ATT_BAR();
}
}

template <int WIN>
__device__ __forceinline__ void pool_item(int g, int tok0, int lane, int r32, int hi, LAS unsigned char* st, const bf16_t* qkvp, const bf16_t* wpT, const float* pscale, bf16_t* mix) {
    constexpr int HALFW = WIN / 2, NR = 32 + WIN - 1, PITCH = 272;
    const int s0 = tok0 & (SEQ - 1);
    { const bf16_t* base = qkvp + (size_t)tok0 * INW + 1536 + g * 128 + 8 * (lane & 15);
      constexpr int NB = (NR + 3) / 4;
      u32x4 v[NB];
#pragma unroll
      for (int i = 0; i < NB; ++i) { const int ri = 4 * i + (lane >> 4), sp = min(max(s0 - HALFW + ri, 0), SEQ - 1);
          v[i] = *(const u32x4*)(base + (long)(sp - s0) * INW); }
#pragma unroll
      for (int i = 0; i < NB; ++i) { const int ri = 4 * i + (lane >> 4), sp = s0 - HALFW + ri;
          const bool ok = (sp >= 0 && sp < SEQ);
          u32x4 z; z.x = ok ? v[i].x : 0u; z.y = ok ? v[i].y : 0u; z.z = ok ? v[i].z : 0u; z.w = ok ? v[i].w : 0u;
          *(LAS u32x4*)(st + ri * PITCH + (lane & 15) * 16) = z; } }
    asm volatile("s_waitcnt lgkmcnt(0)" ::: "memory");
    const int s = s0 + r32;
    const int lo = max(s - HALFW, 0), hi_ = min(s - HALFW + WIN - 1, SEQ - 1);
    const float rc = 1.0f / (float)(hi_ - lo + 1);
    f32x16 acc[4];
#pragma unroll
    for (int cb = 0; cb < 4; ++cb)
#pragma unroll
        for (int r = 0; r < 16; ++r) acc[cb][r] = 0.f;
    const LAS unsigned char* lrow = st + r32 * PITCH + hi * 16;
#pragma unroll (WIN <= 4 ? 4 : (WIN == 8 ? 2 : 1))
    for (int ks = 0; ks < 8; ++ks) {
        bf16x8 bfr[4];
#pragma unroll
        for (int cb = 0; cb < 4; ++cb) bfr[cb] = *(const bf16x8*)(wpT + (size_t)(g * 128 + 32 * cb + r32) * 128 + 16 * ks + 8 * hi);
        float sum[8];
#pragma unroll
        for (int i = 0; i < 8; ++i) sum[i] = 0.f;
        u32x4 own;
#pragma unroll
        for (int j = 0; j < WIN; ++j) { const u32x4 v = *(const LAS u32x4*)(lrow + j * PITCH + 32 * ks); if (j == HALFW) own = v;
#pragma unroll
            for (int i = 0; i < 4; ++i) { sum[2 * i] += __builtin_bit_cast(float, v[i] << 16); sum[2 * i + 1] += __builtin_bit_cast(float, v[i] & 0xffff0000u); } }
        u32x4 aw;
#pragma unroll
        for (int i = 0; i < 4; ++i) { const float o0 = __builtin_bit_cast(float, own[i] << 16), o1 = __builtin_bit_cast(float, own[i] & 0xffff0000u);
            aw[i] = pk2(sum[2 * i] * rc - o0, sum[2 * i + 1] * rc - o1); }
        const bf16x8 af = __builtin_bit_cast(bf16x8, aw);
#pragma unroll
        for (int cb = 0; cb < 4; ++cb) acc[cb] = __builtin_amdgcn_mfma_f32_32x32x16_bf16(af, bfr[cb], acc[cb], 0, 0, 0);
    }
    asm volatile("s_waitcnt lgkmcnt(0)" ::: "memory");
#pragma unroll
    for (int cb = 0; cb < 4; ++cb) { const float ps = pscale[g * 128 + 32 * cb + r32];
#pragma unroll
        for (int r = 0; r < 16; ++r) { const int row = tok0 + (r & 3) + 8 * (r >> 2) + 4 * hi; mix[(size_t)row * D + 512 + g * 128 + 32 * cb + r32] = (bf16_t)f2bf(acc[cb][r] * ps); } }
}
__device__ __forceinline__ void pool_phase(const Frame& Fi, const bf16_t* qkvp, const bf16_t* wpT, const float* pscale, bf16_t* mix) {
    Frame F = refresh(Fi);
    const int lane = F.lane;
    const int gw = F.vcu * NWAVES + F.wave, NGW = F.G * NWAVES;
    LAS unsigned char* st = F.lds + F.wave * 16384;
    for (int it = gw; it < (NTOK / 32) * 4; it += NGW) {
        const int g = (it >= (NTOK / 32) * 2) ? 3 - (it & 3) : (it & 3), tok0 = (it >> 2) * 32;
        int r32 = lane & 31, hi = lane >> 5; asm volatile("" : "+v"(r32), "+v"(hi));
        if (g == 0) pool_item<2>(0, tok0, lane, r32, hi, st, qkvp, wpT, pscale, mix);
        else if (g == 1) pool_item<4>(1, tok0, lane, r32, hi, st, qkvp, wpT, pscale, mix);
        else if (g == 2) pool_item<8>(2, tok0, lane, r32, hi, st, qkvp, wpT, pscale, mix);
        else pool_item<16>(3, tok0, lane, r32, hi, st, qkvp, wpT, pscale, mix);
    }
}

__device__ __forceinline__ void router_phase(const Frame& Fi, const bf16_t* X, const float* g2, const float* wr, const float* br, unsigned* gcnt, int* tl, u32x2* gd, bf16_t* H2) {
    Frame F = refresh(Fi);
    const int lane = F.lane, w = F.wave, r32 = lane & 31, hi = lane >> 5;
    LAS unsigned char* xs = F.lds;
    LAS float* part = (LAS float*)(F.lds + 131584);
    LAS int* cntl = (LAS int*)(F.lds + 160256);
    LAS int* gbs = (LAS int*)(F.lds + 160384);
    LAS float* rs = (LAS float*)(F.lds + 160512);
    bf16x8 ap[8][3];
#pragma unroll
    for (int q = 0; q < 8; ++q) { unsigned pc[3][4];
#pragma unroll
        for (int i = 0; i < 8; ++i) { const int k = 128 * w + 16 * q + 8 * hi + i; const float a = wr[k * NE + r32] * g2[k];
            const unsigned b0 = __builtin_bit_cast(unsigned, a) & 0xffff0000u; const float r1 = a - __builtin_bit_cast(float, b0);
            const unsigned b1 = __builtin_bit_cast(unsigned, r1) & 0xffff0000u; const float r2 = r1 - __builtin_bit_cast(float, b1);
            const unsigned b2 = __builtin_bit_cast(unsigned, r2) & 0xffff0000u;
            if (i & 1) { pc[0][i >> 1] |= b0; pc[1][i >> 1] |= b1; pc[2][i >> 1] |= b2; } else { pc[0][i >> 1] = b0 >> 16; pc[1][i >> 1] = b1 >> 16; pc[2][i >> 1] = b2 >> 16; } }
#pragma unroll
        for (int c = 0; c < 3; ++c) ap[q][c] = __builtin_bit_cast(bf16x8, (u32x4){pc[c][0], pc[c][1], pc[c][2], pc[c][3]}); }
    u32x2 v[4][4];
    const f32x4 gq = *((const GAS f32x4*)g2 + 32 * w + r32);
    int item = F.vcu;
    if (item < NTOK / 32) {
#pragma unroll
        for (int q = 0; q < 4; ++q) load_row16(X + (size_t)(item * 32 + 4 * w + q) * D, lane, v[q]);
    }
    for (; item < NTOK / 32; item += F.G) {
        const int tok0 = item * 32;
        if (F.tid < 32) cntl[F.tid] = 0;
#pragma unroll
        for (int q = 0; q < 4; ++q) { const int r = 4 * w + q; float ss = 0.f;
#pragma unroll
            for (int j = 0; j < 4; ++j) { const f32x4 x = up4(v[q][j]); ss += (x.x * x.x + x.y * x.y) + (x.z * x.z + x.w * x.w);
                *(LAS f32x4*)(xs + r * 4096 + (((lane + 64 * j) ^ (r & 15)) << 4)) = x; }
            ss = wave_sum(ss);
            if (lane == 0) rs[r] = 1.0f / sqrtf(ss * (1.f / D) + EPS); }
        if (item + F.G < NTOK / 32) {
#pragma unroll
            for (int q = 0; q < 4; ++q) load_row16(X + (size_t)((item + F.G) * 32 + 4 * w + q) * D, lane, v[q]);
        }
        __syncthreads();
        f32x16 acc;
#pragma unroll
        for (int r = 0; r < 16; ++r) acc[r] = 0.f;
        { const LAS unsigned char* xr = xs + r32 * 4096;
#pragma unroll
          for (int q = 0; q < 8; ++q) { const int c = 32 * w + 4 * q + 2 * hi;
              const u32x4 x0 = *(const LAS u32x4*)(xr + ((c ^ (r32 & 15)) << 4)), x1 = *(const LAS u32x4*)(xr + (((c + 1) ^ (r32 & 15)) << 4));
              const bf16x8 xb = __builtin_bit_cast(bf16x8, (u32x4){__builtin_amdgcn_perm(x0.y, x0.x, 0x07060302u), __builtin_amdgcn_perm(x0.w, x0.z, 0x07060302u),
                                                                    __builtin_amdgcn_perm(x1.y, x1.x, 0x07060302u), __builtin_amdgcn_perm(x1.w, x1.z, 0x07060302u)});
#pragma unroll
              for (int pcs = 0; pcs < 3; ++pcs) acc = __builtin_amdgcn_mfma_f32_32x32x16_bf16(ap[q][pcs], xb, acc, 0, 0, 0); } }
        if (w > 0) {
#pragma unroll
            for (int r = 0; r < 16; ++r) part[((w - 1) * 16 + r) * 64 + lane] = acc[r]; }
        __syncthreads();
        if (w == 0) {
#pragma unroll
            for (int pw = 0; pw < 7; ++pw)
#pragma unroll
                for (int r = 0; r < 16; ++r) acc[r] += part[(pw * 16 + r) * 64 + lane];
            const float rstd = rs[r32];
            float lv4[16];
#pragma unroll
            for (int r = 0; r < 16; ++r) lv4[r] = acc[r] * rstd + br[(r & 3) + 8 * (r >> 2) + 4 * hi];
            float lv[4]; int le[4];
#pragma unroll
            for (int k = 0; k < 4; ++k) { float best = -INFINITY; int bi = 0;
#pragma unroll
                for (int r = 0; r < 16; ++r) { const bool gtb = lv4[r] > best; best = gtb ? lv4[r] : best; bi = gtb ? r : bi; }
                lv[k] = best; le[k] = (bi & 3) + 8 * (bi >> 2) + 4 * hi;
#pragma unroll
                for (int r = 0; r < 16; ++r) lv4[r] = (r == bi) ? -INFINITY : lv4[r]; }
            float cv[8]; int ce[8];
#pragma unroll
            for (int k = 0; k < 4; ++k) { cv[k] = lv[k]; ce[k] = le[k]; cv[4 + k] = __shfl_xor(lv[k], 32); ce[4 + k] = __shfl_xor(le[k], 32); }
            float tv[4], gt[4]; int te[4], lr[4] = {0, 0, 0, 0};
#pragma unroll
            for (int k = 0; k < 4; ++k) { float best = -INFINITY; int be = 1 << 20, bi = 0;
#pragma unroll
                for (int c = 0; c < 8; ++c) { const bool b = (cv[c] > best) || (cv[c] == best && ce[c] < be); best = b ? cv[c] : best; be = b ? ce[c] : be; bi = b ? c : bi; }
                tv[k] = best; te[k] = be;
#pragma unroll
                for (int c = 0; c < 8; ++c) cv[c] = (c == bi) ? -INFINITY : cv[c]; }
            float den = 0.f;
#pragma unroll
            for (int k = 0; k < 4; ++k) { gt[k] = __expf(tv[k] - tv[0]); den += gt[k]; }
#pragma unroll
            for (int k = 0; k < 4; ++k) gt[k] = gt[k] / den;
            if (hi == 0) {
#pragma unroll
                for (int k = 0; k < 4; ++k) lr[k] = __hip_atomic_fetch_add(cntl + te[k], 1, __ATOMIC_RELAXED, __HIP_MEMORY_SCOPE_WORKGROUP);
            }
            LDS_WAIT(); asm volatile("" ::: "memory");
            if (lane < 32) gbs[lane] = (int)__hip_atomic_fetch_add(gcnt + 64 * lane, (unsigned)cntl[lane], __ATOMIC_RELAXED, __HIP_MEMORY_SCOPE_AGENT);
            LDS_WAIT(); asm volatile("" ::: "memory");
            if (hi == 0) { const int tok = tok0 + r32;
#pragma unroll
                for (int k = 0; k < 4; ++k) { const int rk = gbs[te[k]] + lr[k]; tl[te[k] * NTOK + rk] = tok; gd[te[k] * NTOK + rk] = (u32x2){__builtin_bit_cast(unsigned, gt[k]), (unsigned)(tok * 4 + k)}; } }
        }
#pragma unroll
        for (int q = 0; q < 4; ++q)
#pragma unroll
            for (int j = 0; j < 4; ++j) asm volatile("" : "+v"(v[q][j].x), "+v"(v[q][j].y));
        { const int cc = 32 * w + r32;
#pragma unroll 4
          for (int i = 0; i < 16; ++i) { const int r = 2 * i + hi; const float rstd = rs[r];
              const f32x4 x = *(const LAS f32x4*)(xs + r * 4096 + ((cc ^ (r & 15)) << 4));
              const float rs_ = rstd * pg8::F8_SH;
              *((GAS unsigned*)((unsigned char*)H2 + (size_t)(tok0 + r) * D) + cc) = pk4_fp8(x.x * rs_ * gq.x, x.y * rs_ * gq.y, x.z * rs_ * gq.z, x.w * rs_ * gq.w); } }
        __syncthreads();
    }
}
__device__ __forceinline__ void build_tables(const Frame& Fi, unsigned* gcnt) {
    Frame F = refresh(Fi);
    LAS int* tab = (LAS int*)(F.lds + TAB_OFF);
    if (F.wave == 0) {
        const int c = (F.lane < NE) ? (int)__hip_atomic_load(gcnt + 64 * F.lane, __ATOMIC_RELAXED, __HIP_MEMORY_SCOPE_AGENT) : 0;
        const int tl = (c + 255) >> 8;
        int ps = c, pt = tl;
#pragma unroll
        for (int o = 1; o < 32; o <<= 1) { const int a = __shfl_up(ps, o), b = __shfl_up(pt, o); if (F.lane >= o) { ps += a; pt += b; } }
        if (F.lane < NE) { tab[F.lane + 1] = pt; tab[33 + F.lane + 1] = ps; tab[66 + F.lane] = c; }
        if (F.lane == 0) { tab[0] = 0; tab[33] = 0; }
    }
    __syncthreads();
}
__device__ __forceinline__ void combine_phase(const Frame& Fi, bf16_t* X, const bf16_t* y, const float* gain, bf16_t* hout, float* fout) {
    Frame F = refresh(Fi);
    const int gw = F.vcu * NWAVES + F.wave, NGW = F.G * NWAVES;
    f32x4 gn[4]; load_gain(gain, F.lane, gn);
    for (int tok0 = gw; tok0 < NTOK; tok0 += 2 * NGW) {
        f32x4 v[2][4]; u32x2 xv[2][4]; unsigned w[2][4][4];
#pragma unroll
        for (int q = 0; q < 2; ++q) { const int tok = min(tok0 + q * NGW, NTOK - 1); load_row16(X + (size_t)tok * D, F.lane, xv[q]);
#pragma unroll
            for (int k = 0; k < 4; ++k) { const GAS unsigned* yr = (const GAS unsigned*)((const unsigned char*)y + (size_t)(tok * 4 + k) * D) + F.lane;
#pragma unroll
                for (int j = 0; j < 4; ++j) w[q][k][j] = yr[64 * j]; } }
#pragma unroll
        for (int q = 0; q < 2; ++q) { const int tok = tok0 + q * NGW; if (tok >= NTOK) break;
#pragma unroll
            for (int j = 0; j < 4; ++j) v[q][j] = up4(xv[q][j]);
#pragma unroll
            for (int j = 0; j < 4; ++j) { f32x4 t = (f32x4){0.f, 0.f, 0.f, 0.f};
#pragma unroll
                for (int k = 0; k < 4; ++k) { const unsigned ww = w[q][k][j]; const f32x2 lo = __builtin_amdgcn_cvt_pk_f32_fp8((int)ww, false), hi = __builtin_amdgcn_cvt_pk_f32_fp8((int)ww, true);
                    t.x += lo[0]; t.y += lo[1]; t.z += hi[0]; t.w += hi[1]; }
                v[q][j] += t * (1.0f / pg8::F8_SY); }
            const float rstd = row_rstd(v[q]);
            if (hout) {
                GAS u32x2* xo = (GAS u32x2*)(X + (size_t)tok * D) + F.lane;
#pragma unroll
                for (int j = 0; j < 4; ++j) xo[64 * j] = (u32x2){pk2(v[q][j].x, v[q][j].y), pk2(v[q][j].z, v[q][j].w)};
                store_row_bf16(hout + (size_t)tok * D, F.lane, v[q], gn, rstd);
            } else {
                GAS f32x4* oo = (GAS f32x4*)(fout + (size_t)tok * D) + F.lane;
#pragma unroll
                for (int j = 0; j < 4; ++j) oo[64 * j] = v[q][j] * rstd * gn[j];
            }
        }
    }
}

struct Args { const float* in[22]; float* out; unsigned char* ws; };
typedef __attribute__((address_space(4))) const Args CArgs;
__device__ __forceinline__ CArgs* kargs() { CArgs* p = (CArgs*)__builtin_amdgcn_kernarg_segment_ptr(); asm volatile("" : "+s"(p)); return p; }
__global__ void __launch_bounds__(NWAVES * 64, 2) mk_fwd(Args args) {
    extern __shared__ __attribute__((aligned(16))) unsigned char lds[];
    Frame F;
    F.lds = (LAS unsigned char*)lds; F.ldsg = lds;
    F.tid = threadIdx.x; F.lane = F.tid & 63; F.wave = __builtin_amdgcn_readfirstlane(F.tid >> 6);
    F.G = gridDim.x; { const int bx = blockIdx.x; F.vcu = (F.G % 8 == 0) ? (bx % 8) * (F.G / 8) + bx / 8 : bx; }
    unsigned* ctl = (unsigned*)(kargs()->ws + WS_CTL);
    for (int u = F.tid; u < (LDS_BYTES - LDSCTL_OFF) / 4; u += NWAVES * 64) ((LAS unsigned*)(F.lds + LDSCTL_OFF))[u] = 0u;
    __syncthreads();
    (void)xcd_barrier_post(ctl + CW_BAR, (volatile LAS unsigned*)(F.lds + MISC_OFF) + 8);

#define IN(i) (kargs()->in[i])
#define WSP(off) (kargs()->ws + (off))
#define x_in IN(0)
#define rel_table IN(1)
#define norm1 IN(2)
#define w_in IN(3)
#define lq1 IN(4)
#define lk1 IN(5)
#define lq2 IN(6)
#define lk2 IN(7)
#define subln_g IN(8)
#define w_pool IN(9)
#define pool_scale IN(10)
#define w_out IN(11)
#define norm2 IN(12)
#define w_router IN(13)
#define b_router IN(14)
#define w_gate IN(15)
#define b_gate IN(16)
#define w_up IN(17)
#define b_up IN(18)
#define w_down IN(19)
#define b_down IN(20)
#define final_norm IN(21)
#define WIN ((bf16_t*)WSP(WS_WIN))
#define WOUT ((bf16_t*)WSP(WS_WOUT))
#define WPOOL ((bf16_t*)WSP(WS_WPOOL))
#define WGU ((bf16_t*)WSP(WS_WGU))
#define WDN ((bf16_t*)WSP(WS_WDN))
#define X ((bf16_t*)WSP(WS_X))
#define VT ((unsigned char*)WSP(WS_X + 64 * MiB))
#define QKVP ((bf16_t*)WSP(RA_QKVP))
#define MIX ((bf16_t*)WSP(RA_MIX))
#define H ((bf16_t*)WSP(RA_H))
#define ACT ((bf16_t*)WSP(WS_RA))
#define H2 ((bf16_t*)WSP(WS_RB))
#define Y ((bf16_t*)WSP(WS_RB))
#define rt_e ((int*)WSP(RT_E))
#define rt_rank ((int*)WSP(RT_RANK))
#define rt_tl ((int*)WSP(RT_TL))
#define rt_gl ((u32x2*)WSP(RT_GL))
    const int gw = F.vcu * NWAVES + F.wave, NGW = F.G * NWAVES;

    {
        LAS float* scr = (LAS float*)(F.lds + F.wave * 16384);
        constexpr int I_IN = (D / 64) * (INW / 32), I_OUT = (D / 64) * (D / 32), I_POOL = 4 * 2 * 4;
        constexpr int PER_L = I_IN + I_OUT + I_POOL;
        for (int it = gw; it < DEPTH * PER_L; it += NGW) {
            const int l = it / PER_L; int r = it % PER_L;
            if (r < I_IN) { const int kb = r / (INW / 32), nb = r % (INW / 32); transpose_item(w_in + (size_t)l * D * INW, D, INW, WIN + (size_t)l * INW * D, 0, scr, 64 * kb, 32 * nb, F.lane); continue; } r -= I_IN;
            if (r < I_OUT) { const int kb = r / (D / 32), nb = r % (D / 32); transpose_item(w_out + (size_t)l * D * D, D, D, WOUT + (size_t)l * D * D, 0, scr, 64 * kb, 32 * nb, F.lane); continue; } r -= I_OUT;
            { const int g = r >> 3, q = r & 7, kb = q >> 2, nb = q & 3; transpose_item(w_pool + (size_t)(l * 4 + g) * 128 * 128, 128, 128, WPOOL + (size_t)(l * 4 + g) * 128 * 128, 0, scr, 64 * kb, 32 * nb, F.lane); }
        }
        convert_experts(F, w_gate, w_up, w_down, WGU, WDN);
        f32x4 gn[4]; load_gain(norm1, F.lane, gn);
        for (int tok = gw; tok < NTOK; tok += NGW) { f32x4 v[4]; load_row(x_in + (size_t)tok * D, F.lane, v); const float rstd = row_rstd(v); store_row_bf16(H + (size_t)tok * D, F.lane, v, gn, rstd); }
    }
    GRID_SYNC();

    for (int l = 0; l < DEPTH; ++l) {
        {
            pg8::Gemm g{H, WIN + (size_t)l * INW * D, D, nullptr}; pg8::DenseOrder S; S.init(NTOK, INW, (int)gridDim.x, (int)blockIdx.x);
            pg8::EpiQkvp E{QKVP};
            pg8::gemm_phase<pg8::EpiQkvp, pg8::DenseOrder>(F.lds, g, S, E);
        }
        GRID_SYNC();
        vt_phase(F, QKVP, VT);
        GRID_SYNC();
        {
            const float lam_init = 0.8f - 0.6f * expf(-0.3f * (float)l);
            const float d1 = wave_sum(lq1[l * 64 + F.lane] * lk1[l * 64 + F.lane]), d2 = wave_sum(lq2[l * 64 + F.lane] * lk2[l * 64 + F.lane]);
            const float lam = expf(d1) - expf(d2) + lam_init;
            const Frame Fa = refresh(F);
            const int xcd = Fa.vcu / (Fa.G / 8), j = Fa.vcu % (Fa.G / 8), per = Fa.G / 8;
            for (int bh2 = 0; bh2 < 2; ++bh2)
                for (int qb = j; qb < SEQ / 128; qb += per) {
                    const int bh = 2 * xcd + bh2;
                    att::attn_unit(bh >> 2, bh & 3, qb, QKVP, VT, MIX, F.ldsg, rel_table, lam, subln_g + l * 128, 1.0f - lam_init);
                }
            pool_phase(F, QKVP, WPOOL + (size_t)l * 4 * 128 * 128, pool_scale + l * 512, MIX);
        }
        GRID_SYNC();
        {
            pg8::Gemm g{MIX, WOUT + (size_t)l * D * D, D, nullptr}; pg8::DenseOrder S; S.init(NTOK, D, (int)gridDim.x, (int)blockIdx.x);
            pg8::EpiResid E{l == 0 ? x_in : nullptr, X, X};
            pg8::gemm_phase<pg8::EpiResid, pg8::DenseOrder>(F.lds, g, S, E);
        }
        GRID_SYNC();
        unsigned* gcnt = (unsigned*)(kargs()->ws + WS_CTL) + CW_ECNT + 64 * NE * l;
        router_phase(F, X, norm2 + l * D, w_router + (size_t)l * D * NE, b_router + l * NE, gcnt, rt_tl, rt_gl, H2);
        GRID_SYNC();
        build_tables(F, gcnt);
        const LAS int* tab = (const LAS int*)(F.lds + TAB_OFF);
        const int ntile = rfl(tab[32]);
        {
            pg8::Gemm g{H2, WGU, D / 2, rt_tl}; pg8::MoeOrder S{tab, 8, 2 * D, 128, ntile * 8, (int)gridDim.x, (int)blockIdx.x, 0};
            pg8::EpiSwiglu E{ACT, b_gate + (size_t)l * NE * D, b_up + (size_t)l * NE * D};
            pg8::gemm_phase<pg8::EpiSwiglu, pg8::MoeOrder, true, true>(F.lds, g, S, E);
        }
        GRID_SYNC();
        {
            pg8::Gemm g{ACT, WDN, D / 2, nullptr}; pg8::MoeOrder S{tab, 4, D, 256, ntile * 4, (int)gridDim.x, (int)blockIdx.x, 1};
            pg8::EpiDown E{Y, b_down + (size_t)l * NE * D, rt_gl};
            pg8::gemm_phase<pg8::EpiDown, pg8::MoeOrder, false, true>(F.lds, g, S, E);
        }
        GRID_SYNC();
        if (l + 1 < DEPTH) {
            convert_experts(F, w_gate + (size_t)(l + 1) * NE * D * D, w_up + (size_t)(l + 1) * NE * D * D, w_down + (size_t)(l + 1) * NE * D * D, WGU, WDN);
            combine_phase(F, X, Y, norm1 + (l + 1) * D, H, nullptr);
            GRID_SYNC();
        } else {
            combine_phase(F, X, Y, final_norm, nullptr, kargs()->out);
        }
    }
}

extern "C" void kernel_launch(void* const* d_in, const int* in_sizes, int n_in, void* d_out, int out_size, void* d_ws, size_t ws_size, hipStream_t stream) {
    static int grid = 0;
    if (grid == 0) {
        if (n_in != 22 || in_sizes[0] != NTOK * D || out_size != NTOK * D || ws_size < WS_END) { fprintf(stderr, "kernel_launch: unexpected shapes (n_in %d, in0 %d, out %d, ws %zu)\n", n_in, n_in > 0 ? in_sizes[0] : -1, out_size, ws_size); grid = -1; return; }
        int dev = 0, cus = 0, per_cu = 0;
        if (hipGetDevice(&dev) != hipSuccess || hipDeviceGetAttribute(&cus, hipDeviceAttributeMultiprocessorCount, dev) != hipSuccess) { grid = -1; return; }
        if (hipFuncSetAttribute((const void*)mk_fwd, hipFuncAttributeMaxDynamicSharedMemorySize, LDS_BYTES) != hipSuccess) { fprintf(stderr, "kernel_launch: hipFuncSetAttribute failed\n"); grid = -1; return; }
        if (hipOccupancyMaxActiveBlocksPerMultiprocessor(&per_cu, (const void*)mk_fwd, NWAVES * 64, LDS_BYTES) != hipSuccess || per_cu < 1) fprintf(stderr, "kernel_launch: occupancy query reports %d\n", per_cu);
        (void)hipGetLastError();
        grid = cus;
        if (grid != 256) { fprintf(stderr, "kernel_launch: built for a 256-CU device (the expert-GEMM gather table holds 17 units per workgroup); found %d CUs, nothing launched\n", cus); grid = -1; return; }
    }
    if (grid < 0) return;
    if (hipMemsetAsync((char*)d_ws + WS_CTL, 0, CTL_ZERO_BYTES, stream) != hipSuccess) return;
    Args a{};
    for (int i = 0; i < 22; ++i) a.in[i] = (const float*)d_in[i];
    a.out = (float*)d_out; a.ws = (unsigned char*)d_ws;
    hipLaunchKernelGGL(mk_fwd, dim3(grid), dim3(NWAVES * 64), LDS_BYTES, stream, a);
}
```
